# Optimizing an MI355X kernel written in HIP

```python
import jax, jax.numpy as jnp
from jax import lax
import numpy as np

D_MODEL = 1024
BATCH = 2
SEQ = 8192
DEPTH = 2

N_META = 16
N_A_LAYERS = DEPTH // 2
N_B_LAYERS = DEPTH - N_A_LAYERS
M_HEADS = 4
M_DV = D_MODEL // M_HEADS
M_DK = M_DV // 2
M_CHUNK = 64
GATE_CAP = 15.0
M_PROJ = 2 * M_HEADS * M_DK + 2 * D_MODEL + 2 * M_HEADS
F_HEADS = 16
F_HD = D_MODEL // F_HEADS
Q_BLOCK = 128
N_GROUPS = 4
EXP_PER_GROUP = 4
N_EXPERTS = N_GROUPS * EXP_PER_GROUP
TOP_K_IN_GROUP = 2
D_EXPERT = D_MODEL // 4
EPS = 1e-6
NEG = -1e30

kernel_name = "mlstm_fox_yoco_hmoe_trunk"


def rmsnorm(x, g):
    xf = x.astype(jnp.float32)
    y = xf * lax.rsqrt(jnp.mean(xf * xf, axis=-1, keepdims=True) + EPS)
    return (y * g.astype(jnp.float32)).astype(x.dtype)


def _heads(t, n, d):
    b, l = t.shape[:2]
    return t.reshape(b, l, n, d).transpose(0, 2, 1, 3)


def mlstm_mixer(h, w_in, b_gate, g_out, w_out):
    B, L, _ = h.shape
    f32 = jnp.float32
    qk_w = M_HEADS * M_DK
    proj = h @ w_in
    q, k, v, o, gates = jnp.split(proj, [qk_w, 2 * qk_w, 2 * qk_w + D_MODEL, 2 * qk_w + 2 * D_MODEL], axis=-1)
    gates = gates.astype(f32) + b_gate.astype(f32)
    gates = GATE_CAP * jnp.tanh(gates / GATE_CAP)
    i_pre = gates[..., :M_HEADS].transpose(0, 2, 1)
    log_f = jax.nn.log_sigmoid(gates[..., M_HEADS:]).transpose(0, 2, 1)
    pad = M_CHUNK - N_META
    def pad_seq(t, val=0.0):
        return jnp.pad(t, [(0, 0), (0, 0), (pad, 0)] + [(0, 0)] * (t.ndim - 3), constant_values=val)
    q = pad_seq(_heads(q, M_HEADS, M_DK).astype(f32) * (M_DK ** -0.5))
    k = pad_seq(_heads(k, M_HEADS, M_DK).astype(f32))
    v = pad_seq(_heads(v, M_HEADS, M_DV).astype(f32))
    li = pad_seq(i_pre, NEG)
    lf = pad_seq(log_f, 0.0)
    Lp = L + pad
    NC = Lp // M_CHUNK
    def chunk(t):
        return t.reshape(t.shape[:2] + (NC, M_CHUNK) + t.shape[3:])
    q, k, v, li, lf = chunk(q), chunk(k), chunk(v), chunk(li), chunk(lf)
    b = jnp.cumsum(lf, axis=-1)
    g_tot = b[..., -1]
    a = g_tot[..., None] - b + li
    m_loc = jnp.max(a, axis=-1)
    wts = jnp.exp(a - m_loc[..., None])
    kv_loc = jnp.einsum('bhncd,bhnce->bhnde', k * wts[..., None], v)
    n_loc = jnp.einsum('bhncd,bhnc->bhnd', k, wts)

    def step(carry, inp):
        c_prev, n_prev, m_prev = carry
        g, m_l, kv_l, n_l = inp
        m_new = jnp.maximum(g + m_prev, m_l)
        s_old = jnp.exp(g + m_prev - m_new)
        s_loc = jnp.exp(m_l - m_new)
        c_new = s_old[..., None, None] * c_prev + s_loc[..., None, None] * kv_l
        n_new = s_old[..., None] * n_prev + s_loc[..., None] * n_l
        return (c_new, n_new, m_new), (c_prev, n_prev, m_prev)

    init = (jnp.zeros((B, M_HEADS, M_DK, M_DV), f32), jnp.zeros((B, M_HEADS, M_DK), f32),
            jnp.zeros((B, M_HEADS), f32))
    mv = lambda t: jnp.moveaxis(t, 2, 0)
    _, (c_st, n_st, m_st) = lax.scan(step, init, (mv(g_tot), mv(m_loc), mv(kv_loc), mv(n_loc)))
    c_st = jnp.moveaxis(c_st, 0, 2)
    n_st = jnp.moveaxis(n_st, 0, 2)
    m_st = jnp.moveaxis(m_st, 0, 2)
    causal = jnp.tril(jnp.ones((M_CHUNK, M_CHUNK), bool))
    dmat = jnp.where(causal, b[..., :, None] - b[..., None, :] + li[..., None, :], NEG)
    bq = b + m_st[..., None]
    m_t = jnp.maximum(jnp.max(dmat, axis=-1), bq)
    s_mat = jnp.einsum('bhncd,bhnsd->bhncs', q, k) * jnp.exp(dmat - m_t[..., None])
    inter = jnp.exp(bq - m_t)
    num = (jnp.einsum('bhncs,bhnse->bhnce', s_mat, v)
           + inter[..., None] * jnp.einsum('bhncd,bhnde->bhnce', q, c_st))
    den = s_mat.sum(-1) + inter * jnp.einsum('bhncd,bhnd->bhnc', q, n_st)
    hout = num / jnp.maximum(jnp.abs(den), jnp.exp(-m_t))[..., None]
    hout = hout.reshape(B, M_HEADS, Lp, M_DV)[:, :, pad:].transpose(0, 2, 1, 3)
    hout = rmsnorm(hout.astype(h.dtype), g_out)
    hout = hout * jax.nn.sigmoid(o.astype(f32)).astype(h.dtype).reshape(B, L, M_HEADS, M_DV)
    return hout.reshape(B, L, D_MODEL) @ w_out


def shared_kv(s, g_kv, w_kv, b_fg, g_k):
    h = rmsnorm(s, g_kv)
    k, v, f_pre = jnp.split(h @ w_kv, [D_MODEL, 2 * D_MODEL], axis=-1)
    k = rmsnorm(_heads(k, F_HEADS, F_HD), g_k)
    v = _heads(v, F_HEADS, F_HD)
    log_f = jax.nn.log_sigmoid(f_pre.astype(jnp.float32) + b_fg.astype(jnp.float32))
    F = jnp.cumsum(log_f, axis=1).transpose(0, 2, 1)
    return k, v, F


def fox_mixer(h, w_q, g_q, w_o, k, v, F):
    B, S, _ = h.shape
    L = k.shape[2]
    q = rmsnorm(_heads(h @ w_q, F_HEADS, F_HD), g_q) * (F_HD ** -0.5)
    nb = S // Q_BLOCK
    qb = q.reshape(B, F_HEADS, nb, Q_BLOCK, F_HD).transpose(2, 0, 1, 3, 4)
    fqb = F[:, :, N_META:].reshape(B, F_HEADS, nb, Q_BLOCK).transpose(2, 0, 1, 3)
    qpos = (N_META + jnp.arange(S, dtype=jnp.int32)).reshape(nb, Q_BLOCK)
    kpos = jnp.arange(L, dtype=jnp.int32)

    def block(args):
        qi, fi, pi = args
        s = (jnp.einsum('bhqd,bhkd->bhqk', qi, k).astype(jnp.float32)
             + fi[..., None] - F[:, :, None, :])
        s = jnp.where(kpos[None, :] <= pi[:, None], s, NEG)
        p = jax.nn.softmax(s, axis=-1).astype(v.dtype)
        return jnp.einsum('bhqk,bhkd->bhqd', p, v)

    o = lax.map(block, (qb, fqb, qpos))
    o = o.transpose(1, 0, 3, 2, 4).reshape(B, S, D_MODEL)
    return o @ w_o


def hier_moe(h, w_group, b_group, w_router, b_router, w_gate, w_up, w_down):
    shp = h.shape
    x = h.reshape(-1, D_MODEL)
    T = x.shape[0]
    f32 = jnp.float32
    gl = (x @ w_group).astype(f32) + b_group.astype(f32)
    top_g = jnp.argmax(gl, axis=-1)
    p_g = jnp.take_along_axis(jax.nn.softmax(gl, axis=-1), top_g[:, None], axis=-1)
    el = ((x @ w_router).astype(f32) + b_router.astype(f32)).reshape(T, N_GROUPS, EXP_PER_GROUP)
    el_g = jnp.take_along_axis(el, top_g[:, None, None], axis=1)[:, 0]
    top_v, top_i = lax.top_k(el_g, TOP_K_IN_GROUP)
    p_e = jax.nn.softmax(top_v, axis=-1) * p_g
    eidx = top_g[:, None] * EXP_PER_GROUP + top_i
    gates = (jax.nn.one_hot(eidx, N_EXPERTS, dtype=f32) * p_e[..., None]).sum(1).astype(x.dtype)
    y = jnp.zeros_like(x)
    for grp in range(N_GROUPS):
        sl = slice(grp * EXP_PER_GROUP, (grp + 1) * EXP_PER_GROUP)
        hg = jnp.einsum('td,edf->tef', x, w_gate[sl])
        hu = jnp.einsum('td,edf->tef', x, w_up[sl])
        act = jax.nn.silu(hg) * hu * gates[:, sl, None]
        y = y + jnp.einsum('tef,efd->td', act, w_down[sl])
    return y.reshape(shp)


def setup_inputs(seed: int = 0) -> dict:
    key = jax.random.key(seed)
    ks = jax.random.split(key, 24)
    f32 = jnp.float32
    def nrm(k, shape, fan):
        return jax.random.normal(k, shape, f32) * (fan ** -0.5)
    def gain(k, shape):
        return 1.0 + 0.02 * jax.random.normal(k, shape, f32)
    NA, NB = N_A_LAYERS, N_B_LAYERS
    kb1, kb2 = jax.random.split(ks[4])
    m_b_gate = jnp.concatenate([
        -2.0 + 0.5 * jax.random.normal(kb1, (NA, M_HEADS), f32),
        jax.random.uniform(kb2, (NA, M_HEADS), f32, 3.0, 6.0)], axis=-1)
    return {
        "x": jax.random.normal(ks[0], (BATCH, SEQ, D_MODEL), f32),
        "meta_tokens": jax.random.normal(ks[1], (N_META, D_MODEL), f32),
        "norm_mix": gain(ks[2], (DEPTH, D_MODEL)),
        "norm_ffn": gain(ks[3], (DEPTH, D_MODEL)),
        "m_w_in": nrm(ks[5], (NA, D_MODEL, M_PROJ), D_MODEL),
        "m_b_gate": m_b_gate,
        "m_g_out": gain(ks[6], (NA, M_HEADS, M_DV)),
        "m_w_out": nrm(ks[7], (NA, D_MODEL, D_MODEL), D_MODEL),
        "kv_norm": gain(ks[8], (D_MODEL,)),
        "kv_w": nrm(ks[9], (D_MODEL, 2 * D_MODEL + F_HEADS), D_MODEL),
        "kv_b_f": jax.random.uniform(ks[10], (F_HEADS,), f32, 1.0, 6.0),
        "k_norm": gain(ks[11], (F_HD,)),
        "f_w_q": nrm(ks[12], (NB, D_MODEL, D_MODEL), D_MODEL),
        "f_q_norm": gain(ks[13], (NB, F_HD)),
        "f_w_o": nrm(ks[14], (NB, D_MODEL, D_MODEL), D_MODEL),
        "moe_w_group": nrm(ks[15], (DEPTH, D_MODEL, N_GROUPS), D_MODEL),
        "moe_b_group": 0.01 * jax.random.normal(ks[16], (DEPTH, N_GROUPS), f32),
        "moe_w_router": nrm(ks[17], (DEPTH, D_MODEL, N_EXPERTS), D_MODEL),
        "moe_b_router": 0.01 * jax.random.normal(ks[18], (DEPTH, N_EXPERTS), f32),
        "moe_w_gate": nrm(ks[19], (DEPTH, N_EXPERTS, D_MODEL, D_EXPERT), D_MODEL),
        "moe_w_up": nrm(ks[20], (DEPTH, N_EXPERTS, D_MODEL, D_EXPERT), D_MODEL),
        "moe_w_down": nrm(ks[21], (DEPTH, N_EXPERTS, D_EXPERT, D_MODEL), D_EXPERT),
    }


def reference(x, meta_tokens, norm_mix, norm_ffn, m_w_in, m_b_gate, m_g_out, m_w_out,
              kv_norm, kv_w, kv_b_f, k_norm, f_w_q, f_q_norm, f_w_o,
              moe_w_group, moe_b_group, moe_w_router, moe_b_router,
              moe_w_gate, moe_w_up, moe_w_down):
    B = x.shape[0]
    meta = jnp.broadcast_to(meta_tokens[None].astype(x.dtype), (B, N_META, D_MODEL))
    h = jnp.concatenate([meta, x], axis=1)
    k_sh = v_sh = F_sh = None
    for l in range(DEPTH):
        if l < N_A_LAYERS:
            h = h + mlstm_mixer(rmsnorm(h, norm_mix[l]), m_w_in[l], m_b_gate[l], m_g_out[l], m_w_out[l])
        else:
            if l == N_A_LAYERS:
                k_sh, v_sh, F_sh = shared_kv(h, kv_norm, kv_w, kv_b_f, k_norm)
                h = h[:, N_META:]
            j = l - N_A_LAYERS
            h = h + fox_mixer(rmsnorm(h, norm_mix[l]), f_w_q[j], f_q_norm[j], f_w_o[j], k_sh, v_sh, F_sh)
        h = h + hier_moe(rmsnorm(h, norm_ffn[l]), moe_w_group[l], moe_b_group[l], moe_w_router[l],
                         moe_b_router[l], moe_w_gate[l], moe_w_up[l], moe_w_down[l])
    return h
```

```cpp
#include <hip/hip_runtime.h>
#include <cstdio>
#include <cstdint>
namespace pg8 {
#define PG8_LAS __attribute__((address_space(3)))
typedef unsigned short bf16_t;
typedef short bf16x8 __attribute__((ext_vector_type(8)));
typedef float f32x4 __attribute__((ext_vector_type(4)));
typedef unsigned u32x4 __attribute__((ext_vector_type(4)));
constexpr int BM = 256, BK = 64, HALF = 128, HTB = HALF * BK * 2  , STAGE_BYTES = 8 * HTB, NXCD = 8, WGM = 8;

__host__ __device__ __forceinline__ int lds_byte(int r, int c) { const int st = (r >> 4) * 2 + (c >> 5), rr = r & 15, cc = c & 31, ob = rr * 64 + cc * 2; return st * 1024 + (ob ^ (((ob >> 9) & 1) << 5)); }
__host__ __device__ __forceinline__ void stage_rc(int b, int& R, int& C) { const int st = b / 1024, sb = b % 1024, swz = sb ^ (((sb >> 9) & 1) << 5); R = (st >> 1) * 16 + swz / 64; C = (st & 1) * 32 + (swz % 64) / 2; }
__host__ __device__ __forceinline__ int perm32(int rho) { const int n = rho >> 4, i = rho & 15; return 8 * (i >> 2) + 4 * n + (i & 3); }

struct Unit { int pm, pn; };
struct Gemm { const bf16_t* A; const bf16_t* Bt; int M, N, K; };

struct StaticOrder {
    int nM, nN, nwg, G, c;
    __host__ __device__ void init(int M, int N, int G_, int c_) { nM = M / BM; nN = N / BM; nwg = nM * nN; G = G_; c = c_; }
    __host__ __device__ bool next(int i, Unit& u) const {
        const long L = (long)i * G + c; if (L >= nwg) return false;
        int wgid = (int)L; { const int q = nwg / NXCD, r = nwg % NXCD, xcd = wgid % NXCD, off = wgid / NXCD; wgid = (xcd < r ? xcd * (q + 1) : r * (q + 1) + (xcd - r) * q) + off; }
        const int nig = WGM * nN, gid = wgid / nig, fm = gid * WGM, gsz = (nM - fm) < WGM ? (nM - fm) : WGM;
        u.pm = fm + ((wgid % nig) % gsz); u.pn = (wgid % nig) / gsz; return true;
    }
    __device__ __forceinline__ void a_ready(const Unit&) const {}
    __device__ __forceinline__ void done(const Unit&) const {}
};

__device__ __forceinline__ unsigned cvt_pk_bf16(float lo, float hi) { unsigned r; asm volatile("v_cvt_pk_bf16_f32 %0, %1, %2" : "=v"(r) : "v"(lo), "v"(hi)); return r; }
typedef float f32x2 __attribute__((ext_vector_type(2)));
__device__ __forceinline__ f32x2 gelu_pk(f32x2 v) {
    const f32x2 av = __builtin_elementwise_abs(v), d = av * 0.2316418882f + 1.0f;
    f32x2 t; t.x = __builtin_amdgcn_rcpf(d.x); t.y = __builtin_amdgcn_rcpf(d.y);
    f32x2 q = t * 0.5307027145f + (-0.7265760135f); q = q * t + 0.7107068705f; q = q * t + (-0.142248368f); q = q * t + 0.127414796f; q = q * t;
    const f32x2 s = (v * v) * (-0.72134752044f);
    f32x2 e; e.x = __builtin_amdgcn_exp2f(s.x); e.y = __builtin_amdgcn_exp2f(s.y);
    const f32x2 m = v * (q * e), r = v - m;
    f32x2 o; o.x = v.x < 0.f ? m.x : r.x; o.y = v.y < 0.f ? m.y : r.y; return o;
}

template <int ACT  > struct EpiBf16 {
    static constexpr bool PERM = true, AFTER_DRAIN = false; static_assert(ACT == 0 || ACT == 1, "EpiBf16: ACT is 0 (none) or 1 (gelu_pk)");
    bf16_t* O; int ldc; const float* bias; int split_cols; size_t split_stride; float scale0;
    __device__ __forceinline__ void operator()(const f32x4 (&acc)[2][2][4][2], const Unit& u, int wr, int wc, int fr, int fq) const {
        const int row0 = u.pm * BM + wr * 64 + fr; int colt = u.pn * BM; bf16_t* base = O;
        float sc = 1.f; if (split_cols) { const int t = colt / split_cols; base += (size_t)t * split_stride; colt -= t * split_cols; if (t == 0) sc = scale0; }
        const int col0 = colt + wc * 32 + 8 * fq, bcol0 = u.pn * BM + wc * 32 + 8 * fq;
        f32x4 bv[2][2];
#pragma unroll
        for (int bj = 0; bj < 2; ++bj)
#pragma unroll
            for (int n = 0; n < 2; ++n) bv[bj][n] = bias ? *(const f32x4*)(bias + bcol0 + bj * HALF + 4 * n) : (f32x4){0.f, 0.f, 0.f, 0.f};
#pragma unroll
        for (int ai = 0; ai < 2; ++ai)
#pragma unroll
            for (int m = 0; m < 4; ++m) { bf16_t* rowp = base + (size_t)(row0 + ai * HALF + m * 16) * ldc + col0;
#pragma unroll
                for (int bj = 0; bj < 2; ++bj) { f32x4 v0 = acc[ai][bj][m][0] + bv[bj][0], v1 = acc[ai][bj][m][1] + bv[bj][1];
                    if (ACT == 1) { f32x2 a = gelu_pk((f32x2){v0[0], v0[1]}), b = gelu_pk((f32x2){v0[2], v0[3]}), c = gelu_pk((f32x2){v1[0], v1[1]}), d = gelu_pk((f32x2){v1[2], v1[3]});
                        v0 = (f32x4){a.x, a.y, b.x, b.y}; v1 = (f32x4){c.x, c.y, d.x, d.y}; }
                    v0 = v0 * sc; v1 = v1 * sc; u32x4 w; w.x = cvt_pk_bf16(v0[0], v0[1]); w.y = cvt_pk_bf16(v0[2], v0[3]); w.z = cvt_pk_bf16(v1[0], v1[1]); w.w = cvt_pk_bf16(v1[2], v1[3]);
                    *(u32x4*)(rowp + bj * HALF) = w; } }
    }
};
constexpr int X_TR = 16384, X_TALL = 16400, X_SEQ = 8192, X_KVROWS = 8256;
struct EpiResF32 {
    static constexpr bool PERM = false, AFTER_DRAIN = false;
    const float* b0; const float* b1; float* o0; float* o1;
    __device__ __forceinline__ void operator()(const f32x4 (&acc)[2][2][4][2], const Unit& u, int wr, int wc, int fr, int fq) const {
        const int col0 = u.pn * BM + wc * 32 + 4 * fq;
#pragma unroll
        for (int ai = 0; ai < 2; ++ai)
#pragma unroll
            for (int m = 0; m < 4; ++m) {
                const int r = u.pm * BM + ai * HALF + wr * 64 + m * 16 + fr;
                const float* bp; float* op;
                if (r < X_TR) { bp = b0 + (size_t)r * 1024; op = o0 + (size_t)r * 1024; }
                else if (r < X_TALL) { bp = b1 + (size_t)(r - X_TR) * 1024; op = o1 + (size_t)(r - X_TR) * 1024; }
                else continue;
#pragma unroll
                for (int bj = 0; bj < 2; ++bj)
#pragma unroll
                    for (int n = 0; n < 2; ++n) { const int c = col0 + bj * HALF + n * 16; const f32x4 v = *(const f32x4*)(bp + c) + acc[ai][bj][m][n]; *(f32x4*)(op + c) = v; }
            }
    }
};
struct EpiKV {
    static constexpr bool PERM = true, AFTER_DRAIN = false;
    bf16_t* Kb; bf16_t* Vb;
    __device__ __forceinline__ void operator()(const f32x4 (&acc)[2][2][4][2], const Unit& u, int wr, int wc, int fr, int fq) const {
        const int row0 = u.pm * BM + wr * 64 + fr; int colt = u.pn * BM; bf16_t* base = Kb;
        if (colt >= 1024) { base = Vb; colt -= 1024; }
        const int col0 = colt + wc * 32 + 8 * fq;
#pragma unroll
        for (int ai = 0; ai < 2; ++ai)
#pragma unroll
            for (int m = 0; m < 4; ++m) {
                const int r = row0 + ai * HALF + m * 16;
                if (r >= X_TALL) continue;
                size_t d0, d1; bool two = false;
                if (r < X_TR) { d0 = (size_t)(r >> 13) * X_KVROWS + 64 + (r & (X_SEQ - 1)); d1 = d0; }
                else { d0 = (size_t)(r - X_TR); d1 = d0 + X_KVROWS; two = true; }
#pragma unroll
                for (int bj = 0; bj < 2; ++bj) { const f32x4 v0 = acc[ai][bj][m][0], v1 = acc[ai][bj][m][1];
                    u32x4 w; w.x = cvt_pk_bf16(v0[0], v0[1]); w.y = cvt_pk_bf16(v0[2], v0[3]); w.z = cvt_pk_bf16(v1[0], v1[1]); w.w = cvt_pk_bf16(v1[2], v1[3]);
                    *(u32x4*)(base + d0 * 1024 + col0 + bj * HALF) = w;
                    if (two) *(u32x4*)(base + d1 * 1024 + col0 + bj * HALF) = w; }
            }
    }
};
template <class Epi, class Sched, bool ALIGN_EPI = false, bool SP2 = false>
__device__ __forceinline__ void gemm_phase(PG8_LAS unsigned char* lds, const Gemm g, const Sched& S, const Epi& E) {
    const int tid = threadIdx.x, wid = __builtin_amdgcn_readfirstlane(tid >> 6), lane = tid & 63, wr = wid >> 2, wc = wid & 3, fr = lane & 15, fq = lane >> 4;
    const int K = g.K, nt = K / BK;
    unsigned voffA[2], voffB[2];
#pragma unroll
    for (int i = 0; i < 2; ++i) { int R, C; stage_rc(tid * 16 + i * 8192, R, C); const int Rb = Epi::PERM ? ((R & ~31) + perm32(R & 31)) : R;
        voffA[i] = (unsigned)(R * K + C) * 2u; voffB[i] = (unsigned)(Rb * K + C) * 2u; }
    const size_t kstep = (size_t)(BK * 2);
    const size_t hstep = (size_t)HALF * K * 2;
    const size_t tstep = 2 * hstep;
    const unsigned ldsw = (unsigned)wid * 1024u;
    const int aoff = lds_byte(wr * 64 + fr, fq * 8), boff = lds_byte(wc * 32 + fr, fq * 8);
#define PG8_SA(b, h) (((b) * 2 + (h)) * HTB)
#define PG8_SB(b, h) ((4 + (b) * 2 + (h)) * HTB)
#define PG8_STAGE(bufoff, gbase, voff) do { _Pragma("unroll") for (int _i = 0; _i < 2; ++_i) \
        __builtin_amdgcn_global_load_lds((const unsigned*)((const char*)(gbase) + (voff)[_i]), (PG8_LAS unsigned*)(lds + (bufoff) + ldsw + _i * 8192), 16, 0, 0); } while (0)
#define PG8_LDA(dst, b, h) do { _Pragma("unroll") for (int m = 0; m < 4; ++m) _Pragma("unroll") for (int k = 0; k < 2; ++k) dst[m][k] = *(const PG8_LAS bf16x8*)(lds + PG8_SA(b, h) + aoff + m * 2048 + k * 1024); } while (0)
#define PG8_LDB(dst, b, h) do { _Pragma("unroll") for (int n = 0; n < 2; ++n) _Pragma("unroll") for (int k = 0; k < 2; ++k) dst[n][k] = *(const PG8_LAS bf16x8*)(lds + PG8_SB(b, h) + boff + n * 2048 + k * 1024); } while (0)
#define PG8_MMA(ai, bj, At, Bt) do { __builtin_amdgcn_s_setprio(1); _Pragma("unroll") for (int m = 0; m < 4; ++m) _Pragma("unroll") for (int n = 0; n < 2; ++n) _Pragma("unroll") for (int k = 0; k < 2; ++k) \
        acc[ai][bj][m][n] = __builtin_amdgcn_mfma_f32_16x16x32_bf16(Bt[n][k], At[m][k], acc[ai][bj][m][n], 0, 0, 0); __builtin_amdgcn_s_setprio(0); } while (0)
#define PG8_WAIT_V(n) asm volatile("s_waitcnt vmcnt(" #n ")" ::: "memory")
#define PG8_WAIT_L(n) asm volatile("s_waitcnt lgkmcnt(" #n ")" ::: "memory")
#define PG8_BAR __builtin_amdgcn_s_barrier()
#define PG8_SCHED __builtin_amdgcn_sched_barrier(0)
    Unit cur, nxt; int ui = 0;
    if (!S.next(0, cur)) return;
    f32x4 acc[2][2][4][2];
#pragma unroll
    for (int a = 0; a < 2; ++a)
#pragma unroll
        for (int b = 0; b < 2; ++b)
#pragma unroll
            for (int m = 0; m < 4; ++m)
#pragma unroll
                for (int n = 0; n < 2; ++n) acc[a][b][m][n] = (f32x4){0.f, 0.f, 0.f, 0.f};
    bf16x8 At[4][2], B0[2][2], B1[2][2];
    const char* cA = (const char*)g.A + (size_t)cur.pm * tstep; const char* cB = (const char*)g.Bt + (size_t)cur.pn * tstep;
    S.a_ready(cur);
    if constexpr (SP2) {
        PG8_STAGE(PG8_SB(0, 0), cB, voffB); PG8_STAGE(PG8_SB(0, 1), cB + hstep, voffB); PG8_STAGE(PG8_SA(0, 0), cA, voffA); PG8_STAGE(PG8_SA(0, 1), cA + hstep, voffA);
        if (wr == 1) PG8_BAR;
        PG8_WAIT_V(2); PG8_BAR;
        PG8_STAGE(PG8_SB(1, 0), cB + kstep, voffB); PG8_STAGE(PG8_SA(1, 0), cA + kstep, voffA); PG8_STAGE(PG8_SB(1, 1), cB + hstep + kstep, voffB);
        PG8_WAIT_V(6); PG8_BAR;
    } else {
        PG8_STAGE(PG8_SB(0, 0), cB, voffB); PG8_STAGE(PG8_SA(0, 0), cA, voffA); PG8_STAGE(PG8_SB(0, 1), cB + hstep, voffB); PG8_STAGE(PG8_SA(0, 1), cA + hstep, voffA);
        if (wr == 1) PG8_BAR;
        PG8_WAIT_V(4); PG8_BAR;
        PG8_STAGE(PG8_SB(1, 0), cB + kstep, voffB); PG8_STAGE(PG8_SA(1, 0), cA + kstep, voffA); PG8_STAGE(PG8_SB(1, 1), cB + hstep + kstep, voffB);
        PG8_WAIT_V(6); PG8_BAR;
    }
    for (;;) {
        const bool has_next = S.next(ui + 1, nxt);
        const char* nA = has_next ? (const char*)g.A + (size_t)nxt.pm * tstep : cA; const char* nB = has_next ? (const char*)g.Bt + (size_t)nxt.pn * tstep : cB;
        for (int t = 0; t < nt; t += 2) {
            const bool last = (t == nt - 2);
            const char* a1 = cA + (size_t)(t + 1) * kstep;
            const char* a2 = last ? nA : cA + (size_t)(t + 2) * kstep; const char* b2 = last ? nB : cB + (size_t)(t + 2) * kstep;
            const char* a3 = a2 + kstep; const char* b3 = b2 + kstep;
            if (last && has_next) S.a_ready(nxt);
            if constexpr (SP2) {
            PG8_LDB(B0, 0, 0); PG8_LDB(B1, 0, 1); PG8_SCHED; PG8_LDA(At, 0, 0); PG8_STAGE(PG8_SA(1, 1), a1 + hstep, voffA);
            PG8_WAIT_V(8); PG8_WAIT_L(0); PG8_BAR; PG8_MMA(0, 0, At, B0); PG8_MMA(0, 1, At, B1); PG8_BAR; PG8_SCHED;
            PG8_LDA(At, 0, 1); PG8_STAGE(PG8_SB(0, 0), b2, voffB); PG8_STAGE(PG8_SB(0, 1), b2 + hstep, voffB); PG8_STAGE(PG8_SA(0, 0), a2, voffA);
            PG8_WAIT_V(8); PG8_WAIT_L(0); PG8_BAR; PG8_MMA(1, 0, At, B0); PG8_MMA(1, 1, At, B1); PG8_BAR; PG8_SCHED;
            PG8_LDB(B0, 1, 0); PG8_LDB(B1, 1, 1); PG8_SCHED; PG8_LDA(At, 1, 0); PG8_STAGE(PG8_SA(0, 1), a2 + hstep, voffA);
            PG8_WAIT_V(8); PG8_WAIT_L(0); PG8_BAR; PG8_MMA(0, 0, At, B0); PG8_MMA(0, 1, At, B1); PG8_BAR; PG8_SCHED;
            PG8_LDA(At, 1, 1); PG8_STAGE(PG8_SB(1, 0), b3, voffB); PG8_STAGE(PG8_SB(1, 1), b3 + hstep, voffB); PG8_STAGE(PG8_SA(1, 0), a3, voffA);
            PG8_WAIT_V(8); PG8_WAIT_L(0); PG8_BAR; PG8_MMA(1, 0, At, B0); PG8_MMA(1, 1, At, B1); PG8_BAR; PG8_SCHED;
            } else {
            PG8_LDB(B0, 0, 0); PG8_SCHED; PG8_LDA(At, 0, 0); PG8_STAGE(PG8_SA(1, 1), a1 + hstep, voffA);
            PG8_WAIT_L(8); PG8_BAR; PG8_WAIT_L(0); PG8_MMA(0, 0, At, B0); PG8_BAR; PG8_SCHED;
            PG8_LDB(B1, 0, 1); PG8_STAGE(PG8_SB(0, 0), b2, voffB);
            PG8_BAR; PG8_WAIT_L(0); PG8_MMA(0, 1, At, B1); PG8_BAR;
            PG8_LDA(At, 0, 1); PG8_STAGE(PG8_SA(0, 0), a2, voffA);
            PG8_BAR; PG8_WAIT_L(0); PG8_MMA(1, 0, At, B0); PG8_BAR; PG8_SCHED;
            PG8_STAGE(PG8_SB(0, 1), b2 + hstep, voffB);
            PG8_WAIT_V(6); PG8_BAR; PG8_MMA(1, 1, At, B1); PG8_BAR;
            PG8_LDB(B0, 1, 0); PG8_SCHED; PG8_LDA(At, 1, 0); PG8_STAGE(PG8_SA(0, 1), a2 + hstep, voffA);
            PG8_WAIT_L(8); PG8_BAR; PG8_WAIT_L(0); PG8_MMA(0, 0, At, B0); PG8_BAR; PG8_SCHED;
            PG8_LDB(B1, 1, 1); PG8_STAGE(PG8_SB(1, 0), b3, voffB);
            PG8_BAR; PG8_WAIT_L(0); PG8_MMA(0, 1, At, B1); PG8_BAR;
            PG8_LDA(At, 1, 1); PG8_STAGE(PG8_SA(1, 0), a3, voffA);
            PG8_BAR; PG8_WAIT_L(0); PG8_MMA(1, 0, At, B0); PG8_BAR; PG8_SCHED;
            PG8_STAGE(PG8_SB(1, 1), b3 + hstep, voffB);
            PG8_WAIT_V(6); PG8_BAR; PG8_MMA(1, 1, At, B1); PG8_BAR;
            }
        }
        if constexpr (ALIGN_EPI) { if (wr == 0) PG8_BAR; }
        if constexpr (!Epi::AFTER_DRAIN) { E(acc, cur, wr, wc, fr, fq); S.done(cur); }
        if (!has_next) break;
#pragma unroll
        for (int a = 0; a < 2; ++a)
#pragma unroll
            for (int b = 0; b < 2; ++b)
#pragma unroll
                for (int m = 0; m < 4; ++m)
#pragma unroll
                    for (int n = 0; n < 2; ++n) acc[a][b][m][n] = (f32x4){0.f, 0.f, 0.f, 0.f};
        cur = nxt; cA = nA; cB = nB; ++ui;
        if constexpr (ALIGN_EPI) { if (wr == 1) PG8_BAR; }
    }
    PG8_WAIT_V(0);
    if constexpr (!ALIGN_EPI) { if (wr == 0) PG8_BAR; }
    PG8_BAR;
    if constexpr (Epi::AFTER_DRAIN) { E.fused(acc, cur, wr, wc, fr, fq, lds, wid, lane); S.done(cur); }
#undef PG8_SA
#undef PG8_SB
#undef PG8_STAGE
#undef PG8_LDA
#undef PG8_LDB
#undef PG8_MMA
#undef PG8_WAIT_V
#undef PG8_WAIT_L
#undef PG8_BAR
#undef PG8_SCHED
}
}
#define GAS __attribute__((address_space(1)))
#define LAS __attribute__((address_space(3)))
typedef unsigned short bf16;
typedef unsigned v4u __attribute__((ext_vector_type(4)));
typedef float f32x4 __attribute__((ext_vector_type(4)));
typedef short bf16x8 __attribute__((ext_vector_type(8)));
typedef GAS unsigned gu32;
typedef GAS unsigned long long gu64;
#define RLX_AGENT __ATOMIC_RELAXED, __HIP_MEMORY_SCOPE_AGENT
#define LDS_WAIT() asm volatile("s_waitcnt lgkmcnt(0)" ::: "memory")
#define VM_WAIT() asm volatile("s_waitcnt vmcnt(0)" ::: "memory")
__device__ __forceinline__ unsigned long long rt() { return __builtin_amdgcn_s_memrealtime(); }
__device__ __forceinline__ unsigned f2bf(float f) { unsigned u = __builtin_bit_cast(unsigned, f); return (u + 0x7fffu + ((u >> 16) & 1u)) >> 16; }
__device__ __forceinline__ unsigned pk2(float lo, float hi) { return f2bf(lo) | (f2bf(hi) << 16); }

#define XB_TMO      128
#define XB_XCNT(j)  (256  + 64 * (j))
#define XB_XSUB(j)  (1280 + 64 * (j))
#define XB_XGEN(j)  (2304 + 64 * (j))
#define XB_TOP      3328
#define XB_TOPGEN   3392
#define XCD_BAR_WORDS 3456
#define XB_SPIN_CAP (1u << 18)

__device__ __forceinline__ unsigned xb_ld(unsigned* p)              { return __hip_atomic_load(p, __ATOMIC_RELAXED, __HIP_MEMORY_SCOPE_AGENT); }
__device__ __forceinline__ unsigned xb_add(unsigned* p, unsigned v) { return __hip_atomic_fetch_add(p, v, __ATOMIC_RELAXED, __HIP_MEMORY_SCOPE_AGENT); }
__device__ __forceinline__ unsigned xb_xcc_id() { return (unsigned)__builtin_amdgcn_s_getreg((3 << 11) | 20) & 0xFu; }
#define XB_SPIN(cond, bar) do { unsigned _sp = 0; while (cond) { __builtin_amdgcn_s_sleep(1); \
    if ((++_sp & 255u) == 0u) { if (xb_ld(&(bar)[XB_TMO])) break; if (_sp > XB_SPIN_CAP) { atomicAdd(&(bar)[XB_TMO], 1u); break; } } } } while (0)

struct XcdBarrier {
    unsigned* bar; unsigned x;
    volatile LAS unsigned* st;
};

__device__ __forceinline__ XcdBarrier xcd_barrier_post(unsigned* bar, volatile LAS unsigned* st) {
    XcdBarrier b; b.bar = bar; b.x = xb_xcc_id(); b.st = st;
    if (threadIdx.x == 0) (void)xb_add(&bar[XB_XCNT(b.x)], 1u);
    return b;
}
__device__ __forceinline__ void xcd_barrier_complete(unsigned* bar, unsigned x, unsigned& nloc, unsigned& nx) {
    const unsigned G = gridDim.x * gridDim.y * gridDim.z;
    unsigned sum, cnt, mine, sp = 0u;
    for (;;) {
        sum = 0u; cnt = 0u; mine = 0u;
#pragma unroll
        for (unsigned j = 0; j < 16; ++j) { const unsigned c = xb_ld(&bar[XB_XCNT(j)]); sum += c; cnt += (c > 0u) ? 1u : 0u; mine = (j == x) ? c : mine; }
        if (sum == G) break;
        __builtin_amdgcn_s_sleep(1);
        if ((++sp & 255u) == 0u) { if (xb_ld(&bar[XB_TMO])) break; if (sp > XB_SPIN_CAP) { atomicAdd(&bar[XB_TMO], 1u); break; } }
    }
    nloc = mine > 0u ? mine : 1u; nx = cnt > 0u ? cnt : 1u;
}

__device__ __forceinline__ void xcd_barrier(const XcdBarrier& b) {
    asm volatile("s_waitcnt vmcnt(0)" ::: "memory");
    __syncthreads();
    if (threadIdx.x == 0) {
        unsigned* bar = b.bar;
        __builtin_amdgcn_s_waitcnt(0);
        unsigned nloc = b.st[0], nx = b.st[1];
        if (nloc == 0u) { xcd_barrier_complete(bar, b.x, nloc, nx); b.st[0] = nloc; b.st[1] = nx; }
        const unsigned old = xb_add(&bar[XB_XSUB(b.x)], 1u);
        const unsigned gen = old / nloc;
        if (old + 1u == (gen + 1u) * nloc) {
            __builtin_amdgcn_fence(__ATOMIC_RELEASE, "agent");
            asm volatile("s_waitcnt vmcnt(0)" ::: "memory");
            const unsigned og = xb_add(&bar[XB_TOP], 1u);
            const unsigned tg = og / nx;
            if (og + 1u == (tg + 1u) * nx) xb_add(&bar[XB_TOPGEN], 1u);
            else XB_SPIN(xb_ld(&bar[XB_TOPGEN]) == tg, bar);
            __builtin_amdgcn_fence(__ATOMIC_ACQUIRE, "agent");
            xb_add(&bar[XB_XGEN(b.x)], 1u);
            asm volatile("s_waitcnt vmcnt(0)" ::: "memory");
        } else {
            XB_SPIN(xb_ld(&bar[XB_XGEN(b.x)]) == gen, bar);
            __builtin_amdgcn_fence(__ATOMIC_ACQUIRE, "agent");
            asm volatile("s_waitcnt vmcnt(0)" ::: "memory");
        }
    }
    __syncthreads();
}

constexpr int DM = 1024, SEQ = 8192, NBATCH = 2, TR = NBATCH * SEQ, NMETA = 16, TALL = TR + NMETA, TPAD = TR + 256, LPOS = SEQ + NMETA, KVROWS = 8256;
constexpr int NWAVES = 8;
constexpr int NPHASE = 14;
#ifndef MK_N_LAUNCHES
#define MK_N_LAUNCHES 14
#endif
constexpr int N_LAUNCHES = MK_N_LAUNCHES;

constexpr size_t MiB = 1u << 20;
constexpr size_t WS_CTL = 0, CTL_ZERO_BYTES = 1 * MiB;
constexpr size_t WS_WIN = 2 * MiB, WS_WOUT = 8 * MiB, WS_WKV = 10 * MiB, WS_WQ = 14 * MiB, WS_WO = 16 * MiB;
constexpr size_t WS_GATES = 18 * MiB;
constexpr size_t WS_HMETA = 19 * MiB;
constexpr size_t WS_TOKP = 19 * MiB + 128 * 1024;
constexpr size_t WS_FM = 20 * MiB;
constexpr size_t WS_FA = 20 * MiB + 512 * 1024;
constexpr size_t WS_LOGF = 22 * MiB;
constexpr size_t WS_LIST = 24 * MiB;
constexpr size_t WS_XN = 26 * MiB;
constexpr size_t WS_PROJ = 59 * MiB;
constexpr size_t WS_XQ = 59 * MiB, WS_K = 92 * MiB, WS_V = 125 * MiB, WS_Q = 158 * MiB, WS_AO = 191 * MiB;
constexpr int LISTCAP = 16400;
constexpr int CW_BAR = 4096;
constexpr int CW_CNT = 16384;

constexpr int RING_OFF = 0, RING_BYTES = 131072;
constexpr int LDSCTL_OFF = RING_BYTES, MISC_OFF = LDSCTL_OFF + 320;
constexpr int LDS_BYTES = 147456;

typedef unsigned short bf16;
typedef unsigned v4u __attribute__((ext_vector_type(4)));
typedef unsigned v2u __attribute__((ext_vector_type(2)));
typedef float f32x4 __attribute__((ext_vector_type(4)));

__device__ __forceinline__ float wave_sum(float v) {
#pragma unroll
    for (int o = 1; o < 64; o <<= 1) v += __shfl_xor(v, o);
    return v;
}
__device__ __forceinline__ float wave_max(float v) {
#pragma unroll
    for (int o = 1; o < 64; o <<= 1) v = fmaxf(v, __shfl_xor(v, o));
    return v;
}
__device__ __forceinline__ float bflo(unsigned u) { return __uint_as_float(u << 16); }
__device__ __forceinline__ float bfhi(unsigned u) { return __uint_as_float(u & 0xffff0000u); }
__device__ __forceinline__ float log_sigmoidf(float x) { return fminf(x, 0.f) - log1pf(expf(-fabsf(x))); }
__device__ __forceinline__ float dot4(f32x4 a, f32x4 b) { return (a.x * b.x + a.y * b.y) + (a.z * b.z + a.w * b.w); }
__device__ __forceinline__ float dot8bf(v4u a, v4u b) {
    return (bflo(a.x) * bflo(b.x) + bfhi(a.x) * bfhi(b.x)) + (bflo(a.y) * bflo(b.y) + bfhi(a.y) * bfhi(b.y)) +
           (bflo(a.z) * bflo(b.z) + bfhi(a.z) * bfhi(b.z)) + (bflo(a.w) * bflo(b.w) + bfhi(a.w) * bfhi(b.w));
}
__device__ __forceinline__ unsigned long long pack4bf(f32x4 v) { return (unsigned long long)pk2(v.x, v.y) | ((unsigned long long)pk2(v.z, v.w) << 32); }

__device__ __forceinline__ void transpose_item(const float* W, int K, int N, int ldw, bf16* WT, LAS float* scr, int item, int lane) {
    const int nblk = N / 32, kb = item / nblk, nb = item % nblk, k0 = 64 * kb, n0 = 32 * nb;
#pragma unroll 8
    for (int i = 0; i < 32; ++i) { const int kk = 2 * i + (lane >> 5); scr[kk * 33 + (lane & 31)] = W[(size_t)(k0 + kk) * ldw + n0 + (lane & 31)]; }
    LDS_WAIT(); asm volatile("" ::: "memory");
    const int c = lane & 7;
#pragma unroll
    for (int j = 0; j < 4; ++j) { const int n = (lane >> 3) + 8 * j; const LAS float* s = scr + (8 * c) * 33 + n;
        v4u o; o.x = pk2(s[0 * 33], s[1 * 33]); o.y = pk2(s[2 * 33], s[3 * 33]); o.z = pk2(s[4 * 33], s[5 * 33]); o.w = pk2(s[6 * 33], s[7 * 33]);
        *(GAS v4u*)(WT + (size_t)(n0 + n) * K + k0 + 8 * c) = o; }
    LDS_WAIT(); asm volatile("" ::: "memory");
}

__device__ __forceinline__ void ph_prologue(const float* x, const float* meta, const float* gmix0, const float* w_in, const float* b_gate, const float* w_out, const float* kv_w,
                                            const float* w_q, const float* w_o, bf16* Win_t, bf16* Wout_t, bf16* Wkv_t, bf16* Wq_t, bf16* Wo_t, bf16* XN, float* gates,
                                            LAS unsigned char* lds, int gw, int NGW, int tid, int lane, int wave) {
    LAS float* Wl = (LAS float*)lds;
    LAS float* scr = (LAS float*)(lds + 32768 + wave * 8704);
    for (int i = tid; i < 8192; i += 512) { const int d = i >> 3, j = i & 7; Wl[j * 1024 + d] = w_in[(size_t)d * 3080 + 3072 + j]; }
    __syncthreads();
    constexpr int I_IN = 16 * 96, I_SQ = 16 * 32, I_KV = 16 * 64, NITEMS = I_IN + 3 * I_SQ + I_KV;
    for (int it = gw; it < NITEMS; it += NGW) {
        int r = it;
        if (r < I_IN) { transpose_item(w_in, 1024, 3072, 3080, Win_t, scr, r, lane); continue; } r -= I_IN;
        if (r < I_SQ) { transpose_item(w_out, 1024, 1024, 1024, Wout_t, scr, r, lane); continue; } r -= I_SQ;
        if (r < I_KV) { transpose_item(kv_w, 1024, 2048, 2064, Wkv_t, scr, r, lane); continue; } r -= I_KV;
        if (r < I_SQ) { transpose_item(w_q, 1024, 1024, 1024, Wq_t, scr, r, lane); continue; } r -= I_SQ;
        transpose_item(w_o, 1024, 1024, 1024, Wo_t, scr, r, lane);
    }
    for (int r = gw; r < TALL; r += NGW) {
        const float* src = r < TR ? x + (size_t)r * DM : meta + (size_t)(r - TR) * DM;
        f32x4 v[4]; float ss = 0.f;
#pragma unroll
        for (int j = 0; j < 4; ++j) { v[j] = ((const f32x4*)src)[lane + 64 * j]; ss += dot4(v[j], v[j]); }
        const float rstd = rsqrtf(wave_sum(ss) * (1.f / DM) + 1e-6f);
#pragma unroll
        for (int j = 0; j < 4; ++j) { const f32x4 gv = ((const f32x4*)gmix0)[lane + 64 * j]; v[j] = v[j] * rstd * gv;
            ((unsigned long long*)(XN + (size_t)r * DM))[lane + 64 * j] = pack4bf(v[j]); }
        float val = 0.f;
#pragma unroll 1
        for (int c = 0; c < 8; ++c) { float s = 0.f;
#pragma unroll
            for (int j = 0; j < 4; ++j) s += dot4(v[j], ((const LAS f32x4*)(Wl + c * 1024))[lane + 64 * j]);
            s = wave_sum(s); val = (lane == c) ? s : val; }
        if (lane < 8) { val += b_gate[lane]; val = 15.f * tanhf(val * (1.f / 15.f)); if (lane >= 4) val = log_sigmoidf(val); gates[(size_t)r * 8 + lane] = val; }
    }
}

__device__ __forceinline__ void scan_seq(const float* src, int ld, int off, int nh, int nseq, float* Fout, int gw, int NGW, int lane) {
    for (int sq = gw; sq < nseq; sq += NGW) {
        const int b = sq / nh, h = sq % nh, p0 = lane * 129;
        float s = 0.f;
        for (int i = 0; i < 129; ++i) { const int p = p0 + i; if (p < LPOS) { const int row = p < NMETA ? TR + p : b * SEQ + p - NMETA; s += src[(size_t)row * ld + off + h]; } }
        float incl = s;
#pragma unroll
        for (int o = 1; o < 64; o <<= 1) { const float t = __shfl_up(incl, o); if (lane >= o) incl += t; }
        float run = incl - s;
        for (int i = 0; i < 129; ++i) { const int p = p0 + i; if (p < LPOS) { const int row = p < NMETA ? TR + p : b * SEQ + p - NMETA; run += src[(size_t)row * ld + off + h]; Fout[(size_t)sq * LPOS + p] = run; } }
    }
}

__device__ __forceinline__ void ph_mlstm_naive(const bf16* PROJ, const float* gates, const float* Fm, const float* g_out, bf16* HM, int gw, int NGW, int lane) {
    for (int it = gw; it < 4 * TALL; it += NGW) {
        const int r = it >> 2, h = it & 3;
        const int b = r < TR ? r / SEQ : 0, p = r < TR ? NMETA + (r % SEQ) : r - TR;
        const float* Fb = Fm + (size_t)(b * 4 + h) * LPOS; const float Fp = Fb[p];
        v4u q[16];
#pragma unroll
        for (int i = 0; i < 16; ++i) q[i] = ((const v4u*)(PROJ + (size_t)r * 3072 + h * 128))[i];
        float acc0 = 0.f, acc1 = 0.f, acc2 = 0.f, acc3 = 0.f, den = 0.f;
        const int nchunk = p / 64 + 1;
        for (int c = 0; c < nchunk; ++c) {
            const int s = c * 64 + lane; const bool valid = s <= p; const int sc = valid ? s : p;
            const int krow = sc < NMETA ? TR + sc : b * SEQ + sc - NMETA;
            const v4u* kp = (const v4u*)(PROJ + (size_t)krow * 3072 + 512 + h * 128);
            float d = 0.f;
#pragma unroll
            for (int i = 0; i < 16; ++i) d += dot8bf(q[i], kp[i]);
            const float w = valid ? __expf(Fp - Fb[sc] + gates[(size_t)krow * 8 + h]) : 0.f;
            const float cv = w * d; den += cv;
            const int jmax = (p - c * 64) < 63 ? (p - c * 64) : 63;
            for (int j = 0; j <= jmax; ++j) {
                const float cj = __shfl(cv, j); const int sj = c * 64 + j;
                const int vrow = sj < NMETA ? TR + sj : b * SEQ + sj - NMETA;
                const v2u vv = *(const v2u*)(PROJ + (size_t)vrow * 3072 + 1024 + h * 256 + lane * 4);
                acc0 += cj * bflo(vv.x); acc1 += cj * bfhi(vv.x); acc2 += cj * bflo(vv.y); acc3 += cj * bfhi(vv.y);
            }
        }
        den = wave_sum(den);
        const float dn = 1.f / fmaxf(fabsf(den), 1.f);
        acc0 *= dn; acc1 *= dn; acc2 *= dn; acc3 *= dn;
        const float ss = wave_sum((acc0 * acc0 + acc1 * acc1) + (acc2 * acc2 + acc3 * acc3));
        const float rstd = rsqrtf(ss * (1.f / 256.f) + 1e-6f);
        const v2u ov = *(const v2u*)(PROJ + (size_t)r * 3072 + 2048 + h * 256 + lane * 4);
        const f32x4 gv = *(const f32x4*)(g_out + h * 256 + lane * 4);
        f32x4 o;
        o.x = acc0 * rstd * gv.x / (1.f + __expf(-bflo(ov.x))); o.y = acc1 * rstd * gv.y / (1.f + __expf(-bfhi(ov.x)));
        o.z = acc2 * rstd * gv.z / (1.f + __expf(-bflo(ov.y))); o.w = acc3 * rstd * gv.w / (1.f + __expf(-bfhi(ov.y)));
        *(unsigned long long*)(HM + (size_t)r * DM + h * 256 + lane * 4) = pack4bf(o);
    }
}

__device__ __forceinline__ void ph_norm_router(const float* h0, const float* h1, int nrows, const float* g, const float* w_group, const float* b_group, const float* w_router, const float* b_router,
                                               bf16* XN, float* tokp, gu32* cnt, int* list, LAS unsigned char* lds, int gw, int NGW, int tid, int lane) {
    LAS float* Wl = (LAS float*)lds;
    for (int i = tid; i < 4096; i += 512) { const int d = i >> 2, j = i & 3; Wl[j * 1024 + d] = w_group[i]; }
    for (int i = tid; i < 16384; i += 512) { const int d = i >> 4, j = i & 15; Wl[(4 + j) * 1024 + d] = w_router[i]; }
    __syncthreads();
    for (int r = gw; r < nrows; r += NGW) {
        const float* src = r < TR ? h0 + (size_t)r * DM : h1 + (size_t)(r - TR) * DM;
        f32x4 v[4]; float ss = 0.f;
#pragma unroll
        for (int j = 0; j < 4; ++j) { v[j] = ((const f32x4*)src)[lane + 64 * j]; ss += dot4(v[j], v[j]); }
        const float rstd = rsqrtf(wave_sum(ss) * (1.f / DM) + 1e-6f);
#pragma unroll
        for (int j = 0; j < 4; ++j) { const f32x4 gv = ((const f32x4*)g)[lane + 64 * j]; v[j] = v[j] * rstd * gv;
            ((unsigned long long*)(XN + (size_t)r * DM))[lane + 64 * j] = pack4bf(v[j]); }
        float lgv = 0.f;
#pragma unroll 1
        for (int c = 0; c < 20; ++c) { float s = 0.f;
#pragma unroll
            for (int j = 0; j < 4; ++j) s += dot4(v[j], ((const LAS f32x4*)(Wl + c * 1024))[lane + 64 * j]);
            s = wave_sum(s); lgv = (lane == c) ? s : lgv; }
        float lg[20];
#pragma unroll
        for (int c = 0; c < 20; ++c) lg[c] = __shfl(lgv, c);
        float gl[4];
#pragma unroll
        for (int j = 0; j < 4; ++j) gl[j] = lg[j] + b_group[j];
        int tg = 0; float gm = gl[0];
#pragma unroll
        for (int j = 1; j < 4; ++j) if (gl[j] > gm) { gm = gl[j]; tg = j; }
        float gs = 0.f;
#pragma unroll
        for (int j = 0; j < 4; ++j) gs += __expf(gl[j] - gm);
        const float pg = 1.f / gs;
        float el[4];
#pragma unroll
        for (int j = 0; j < 4; ++j) { float e = 0.f;
#pragma unroll
            for (int gg = 0; gg < 4; ++gg) e = (tg == gg) ? (lg[4 + 4 * gg + j] + b_router[4 * gg + j]) : e;
            el[j] = e; }
        int i1 = 0; float v1 = el[0];
#pragma unroll
        for (int j = 1; j < 4; ++j) if (el[j] > v1) { v1 = el[j]; i1 = j; }
        int i2 = -1; float v2 = -3.0e38f;
#pragma unroll
        for (int j = 0; j < 4; ++j) if (j != i1 && el[j] > v2) { v2 = el[j]; i2 = j; }
        const float e21 = __expf(v2 - v1), p1 = pg / (1.f + e21), p2 = pg * e21 / (1.f + e21);
        if (lane == 0) {
            const int e1 = tg * 4 + i1, e2 = tg * 4 + i2;
            const unsigned q1 = __hip_atomic_fetch_add(cnt + e1, 1u, __ATOMIC_RELAXED, __HIP_MEMORY_SCOPE_AGENT);
            const unsigned q2 = __hip_atomic_fetch_add(cnt + e2, 1u, __ATOMIC_RELAXED, __HIP_MEMORY_SCOPE_AGENT);
            list[e1 * LISTCAP + q1] = r * 2; list[e2 * LISTCAP + q2] = r * 2 + 1;
            tokp[2 * r] = p1; tokp[2 * r + 1] = p2;
        }
    }
}

__device__ __forceinline__ void ph_moe_naive(const bf16* XN, const float* tokp, const gu32* cnt, const int* list, const float* Wg, const float* Wu, const float* Wd,
                                             float* h0, float* h1, LAS unsigned char* lds, int bid, int G, int tid) {
    LAS float* xs = (LAS float*)lds;
    LAS float* hu = (LAS float*)(lds + 65536);
    LAS float* act = (LAS float*)(lds + 65536 + 16384);
    LAS int* tks = (LAS int*)(lds + 65536 + 32768);
    int ntl[16]; int total = 0;
#pragma unroll
    for (int e = 0; e < 16; ++e) { const int c = (int)__hip_atomic_load(cnt + e, __ATOMIC_RELAXED, __HIP_MEMORY_SCOPE_AGENT); ntl[e] = (c + 15) >> 4; total += ntl[e]; }
    for (int g = bid; g < total; g += G) {
        int e = 0, ti = g;
#pragma unroll
        for (int k = 0; k < 16; ++k) { if (e == k && ti >= ntl[k]) { ti -= ntl[k]; e = k + 1; } }
        const int ce = (int)__hip_atomic_load(cnt + e, __ATOMIC_RELAXED, __HIP_MEMORY_SCOPE_AGENT);
        const int nv = (ce - ti * 16) < 16 ? (ce - ti * 16) : 16;
        __syncthreads();
        if (tid < 16) tks[tid] = tid < nv ? list[e * LISTCAP + ti * 16 + tid] : -1;
        __syncthreads();
        for (int i = tid; i < 16 * 512; i += 512) { const int t = i >> 9, c2 = i & 511; const int tk = tks[t];
            float a = 0.f, b2 = 0.f; if (tk >= 0) { const unsigned u = *(const unsigned*)(XN + (size_t)(tk >> 1) * DM + 2 * c2); a = bflo(u); b2 = bfhi(u); }
            xs[t * 1024 + 2 * c2] = a; xs[t * 1024 + 2 * c2 + 1] = b2; }
        __syncthreads();
        const int which = tid >> 8, f = tid & 255;
        const float* W = (which ? Wu : Wg) + (size_t)e * 1024 * 256 + f;
        float a16[16];
#pragma unroll
        for (int t = 0; t < 16; ++t) a16[t] = 0.f;
        for (int k = 0; k < 1024; k += 4) {
            const float w0 = W[(size_t)k * 256], w1 = W[(size_t)(k + 1) * 256], w2 = W[(size_t)(k + 2) * 256], w3 = W[(size_t)(k + 3) * 256];
#pragma unroll
            for (int t = 0; t < 16; ++t) { const f32x4 xv = *(const LAS f32x4*)(xs + t * 1024 + k); a16[t] += (xv.x * w0 + xv.y * w1) + (xv.z * w2 + xv.w * w3); }
        }
        if (which) {
#pragma unroll
            for (int t = 0; t < 16; ++t) hu[t * 256 + f] = a16[t];
        }
        __syncthreads();
        if (!which) {
#pragma unroll
            for (int t = 0; t < 16; ++t) { const int tk = tks[t]; const float p = tk >= 0 ? tokp[tk] : 0.f; const float gte = a16[t];
                act[t * 256 + f] = gte / (1.f + __expf(-gte)) * hu[t * 256 + f] * p; }
        }
        __syncthreads();
        float y0[16], y1[16];
#pragma unroll
        for (int t = 0; t < 16; ++t) { y0[t] = 0.f; y1[t] = 0.f; }
        const float* D0 = Wd + (size_t)e * 256 * 1024 + tid;
        for (int k = 0; k < 256; k += 4) {
            float wa[4], wb[4];
#pragma unroll
            for (int i = 0; i < 4; ++i) { wa[i] = D0[(size_t)(k + i) * 1024]; wb[i] = D0[(size_t)(k + i) * 1024 + 512]; }
#pragma unroll
            for (int t = 0; t < 16; ++t) { const f32x4 av = *(const LAS f32x4*)(act + t * 256 + k);
                y0[t] += (av.x * wa[0] + av.y * wa[1]) + (av.z * wa[2] + av.w * wa[3]); y1[t] += (av.x * wb[0] + av.y * wb[1]) + (av.z * wb[2] + av.w * wb[3]); }
        }
#pragma unroll
        for (int t = 0; t < 16; ++t) { const int tk = tks[t]; if (tk >= 0) { const int r = tk >> 1; float* hp = r < TR ? h0 + (size_t)r * DM : h1 + (size_t)(r - TR) * DM;
                atomicAdd(hp + tid, y0[t]); atomicAdd(hp + tid + 512, y1[t]); } }
    }
    __syncthreads();
}

__device__ __forceinline__ void ph_norm_kvq(const float* h0, const float* h1, const float* gkv, const float* gq, const float* kv_w, const float* b_f, bf16* XKV, bf16* XQ, float* logf,
                                            LAS unsigned char* lds, int gw, int NGW, int tid, int lane) {
    LAS float* Wl = (LAS float*)lds;
    for (int i = tid; i < 16384; i += 512) { const int d = i >> 4, j = i & 15; Wl[j * 1024 + d] = kv_w[(size_t)d * 2064 + 2048 + j]; }
    __syncthreads();
    for (int r = gw; r < TALL; r += NGW) {
        const float* src = r < TR ? h0 + (size_t)r * DM : h1 + (size_t)(r - TR) * DM;
        f32x4 v[4]; float ss = 0.f;
#pragma unroll
        for (int j = 0; j < 4; ++j) { v[j] = ((const f32x4*)src)[lane + 64 * j]; ss += dot4(v[j], v[j]); }
        const float rstd = rsqrtf(wave_sum(ss) * (1.f / DM) + 1e-6f);
        if (r < TR) {
#pragma unroll
            for (int j = 0; j < 4; ++j) { const f32x4 gv = ((const f32x4*)gq)[lane + 64 * j]; ((unsigned long long*)(XQ + (size_t)r * DM))[lane + 64 * j] = pack4bf(v[j] * rstd * gv); }
        }
#pragma unroll
        for (int j = 0; j < 4; ++j) { const f32x4 gv = ((const f32x4*)gkv)[lane + 64 * j]; v[j] = v[j] * rstd * gv;
            ((unsigned long long*)(XKV + (size_t)r * DM))[lane + 64 * j] = pack4bf(v[j]); }
        float val = 0.f;
#pragma unroll 1
        for (int c = 0; c < 16; ++c) { float s = 0.f;
#pragma unroll
            for (int j = 0; j < 4; ++j) s += dot4(v[j], ((const LAS f32x4*)(Wl + c * 1024))[lane + 64 * j]);
            s = wave_sum(s); val = (lane == c) ? s : val; }
        if (lane < 16) logf[(size_t)r * 16 + lane] = log_sigmoidf(val + b_f[lane]);
    }
}

__device__ __forceinline__ void headnorm_row(bf16* row, const float* g, float scale, int lane) {
    v4u a = ((v4u*)row)[2 * lane], b = ((v4u*)row)[2 * lane + 1];
    float f[16] = {bflo(a.x), bfhi(a.x), bflo(a.y), bfhi(a.y), bflo(a.z), bfhi(a.z), bflo(a.w), bfhi(a.w), bflo(b.x), bfhi(b.x), bflo(b.y), bfhi(b.y), bflo(b.z), bfhi(b.z), bflo(b.w), bfhi(b.w)};
    float ss = 0.f;
#pragma unroll
    for (int i = 0; i < 16; ++i) ss += f[i] * f[i];
    ss += __shfl_xor(ss, 1); ss += __shfl_xor(ss, 2);
    const float rstd = rsqrtf(ss * (1.f / 64.f) + 1e-6f) * scale;
    const float* gp = g + (lane & 3) * 16;
#pragma unroll
    for (int i = 0; i < 16; ++i) f[i] = f[i] * rstd * gp[i];
    a.x = pk2(f[0], f[1]); a.y = pk2(f[2], f[3]); a.z = pk2(f[4], f[5]); a.w = pk2(f[6], f[7]);
    b.x = pk2(f[8], f[9]); b.y = pk2(f[10], f[11]); b.z = pk2(f[12], f[13]); b.w = pk2(f[14], f[15]);
    ((v4u*)row)[2 * lane] = a; ((v4u*)row)[2 * lane + 1] = b;
}
__device__ __forceinline__ void ph_headnorm(bf16* Q, bf16* K, const float* gq, const float* gk, int gw, int NGW, int lane) {
    for (int r = gw; r < TR; r += NGW) headnorm_row(Q + (size_t)r * DM, gq, 0.125f, lane);
    for (int i = gw; i < NBATCH * LPOS; i += NGW) { const int b = i / LPOS, p = i % LPOS; const int kr = b * KVROWS + (p < NMETA ? p : 48 + p); headnorm_row(K + (size_t)kr * DM, gk, 1.f, lane); }
}

__device__ __forceinline__ void ph_attn_naive(const bf16* Q, const bf16* K, const bf16* V, const float* Fa, bf16* AO, int gw, int NGW, int lane) {
    for (int it = gw; it < NBATCH * 16 * SEQ; it += NGW) {
        const int h = it & 15, rt = it >> 4, b = rt / SEQ, t = rt % SEQ, p = NMETA + t;
        const float* Fb = Fa + (size_t)(b * 16 + h) * LPOS; const float Fq = Fb[p];
        v4u q[8];
#pragma unroll
        for (int i = 0; i < 8; ++i) q[i] = ((const v4u*)(Q + (size_t)rt * DM + h * 64))[i];
        float m = -3.0e38f, l = 0.f, acc = 0.f;
        const int nchunk = p / 64 + 1;
        for (int c = 0; c < nchunk; ++c) {
            const int s = c * 64 + lane; const bool valid = s <= p; const int sc = valid ? s : p;
            const size_t krow = (size_t)b * KVROWS + (sc < NMETA ? sc : 48 + sc);
            const v4u* kp = (const v4u*)(K + krow * DM + h * 64);
            float d = 0.f;
#pragma unroll
            for (int i = 0; i < 8; ++i) d += dot8bf(q[i], kp[i]);
            const float lg = valid ? d + Fq - Fb[sc] : -3.0e38f;
            const float mn = fmaxf(m, wave_max(lg));
            const float sc_old = __expf(m - mn);
            const float pv = valid ? __expf(lg - mn) : 0.f;
            l = l * sc_old + wave_sum(pv); acc *= sc_old; m = mn;
            const int jmax = (p - c * 64) < 63 ? (p - c * 64) : 63;
            for (int j = 0; j <= jmax; ++j) {
                const float pj = __shfl(pv, j); const int sj = c * 64 + j;
                const size_t vrow = (size_t)b * KVROWS + (sj < NMETA ? sj : 48 + sj);
                acc += pj * __uint_as_float((unsigned)V[vrow * DM + h * 64 + lane] << 16);
            }
        }
        AO[(size_t)rt * DM + h * 64 + lane] = (bf16)f2bf(acc / l);
    }
}

struct Args { const float* in[22]; float* out; unsigned char* ws; int ph_lo, ph_hi, li, pad; };
__global__ void __launch_bounds__(NWAVES * 64, 2) trunk_fwd(Args args) {
    extern __shared__ __attribute__((aligned(16))) unsigned char lds_raw[];
    LAS unsigned char* lds = (LAS unsigned char*)lds_raw;
    volatile LAS unsigned* MISC = (volatile LAS unsigned*)(lds + MISC_OFF);
    const int tid = threadIdx.x, lane = tid & 63, wave = __builtin_amdgcn_readfirstlane(tid >> 6);
    const int G = gridDim.x; const int bx = blockIdx.x; const int vcu = (G % 8 == 0) ? (bx % 8) * (G / 8) + bx / 8 : bx;
    const int gw = vcu * NWAVES + wave, NGW = G * NWAVES;
    unsigned char* ws = args.ws;
    gu32* ctl = (gu32*)(ws + WS_CTL);
    const float* x = args.in[0]; const float* meta = args.in[1]; const float* norm_mix = args.in[2]; const float* norm_ffn = args.in[3];
    const float* m_w_in = args.in[4]; const float* m_b_gate = args.in[5]; const float* m_g_out = args.in[6]; const float* m_w_out = args.in[7];
    const float* kv_norm = args.in[8]; const float* kv_w = args.in[9]; const float* kv_b_f = args.in[10]; const float* k_norm = args.in[11];
    const float* f_w_q = args.in[12]; const float* f_q_norm = args.in[13]; const float* f_w_o = args.in[14];
    const float* moe_w_group = args.in[15]; const float* moe_b_group = args.in[16]; const float* moe_w_router = args.in[17]; const float* moe_b_router = args.in[18];
    const float* moe_w_gate = args.in[19]; const float* moe_w_up = args.in[20]; const float* moe_w_down = args.in[21];
    float* out = args.out;
    bf16* Win_t = (bf16*)(ws + WS_WIN); bf16* Wout_t = (bf16*)(ws + WS_WOUT); bf16* Wkv_t = (bf16*)(ws + WS_WKV); bf16* Wq_t = (bf16*)(ws + WS_WQ); bf16* Wo_t = (bf16*)(ws + WS_WO);
    float* gates = (float*)(ws + WS_GATES); float* hmeta = (float*)(ws + WS_HMETA); float* tokp = (float*)(ws + WS_TOKP);
    float* Fm = (float*)(ws + WS_FM); float* Fa = (float*)(ws + WS_FA); float* logf = (float*)(ws + WS_LOGF); int* list = (int*)(ws + WS_LIST);
    bf16* XN = (bf16*)(ws + WS_XN); bf16* PROJ = (bf16*)(ws + WS_PROJ); bf16* XQ = (bf16*)(ws + WS_XQ);
    bf16* Kb = (bf16*)(ws + WS_K); bf16* Vb = (bf16*)(ws + WS_V); bf16* Qb = (bf16*)(ws + WS_Q); bf16* AO = (bf16*)(ws + WS_AO);

    for (int u = tid; u < (LDS_BYTES - LDSCTL_OFF) / 4; u += NWAVES * 64) ((LAS unsigned*)(lds + LDSCTL_OFF))[u] = 0u;
    __syncthreads();
    XcdBarrier bar; bar.bar = (unsigned*)(ctl + CW_BAR); bar.x = 0; bar.st = nullptr;
    if (N_LAUNCHES == 1) bar = xcd_barrier_post((unsigned*)(ctl + CW_BAR), MISC + 8);
    const int lo = args.ph_lo, hi = args.ph_hi;
#ifndef PHASE_MASK
#define PHASE_MASK 0xFFFFF
#endif
#define IN(k) (((PHASE_MASK >> (k)) & 1) && lo <= (k) && (k) < hi)
#define SEAM(k) do { if (IN(k) && IN((k) + 1)) xcd_barrier(bar); } while (0)

    if (IN(0)) { ph_prologue(x, meta, norm_mix, m_w_in, m_b_gate, m_w_out, kv_w, f_w_q, f_w_o, Win_t, Wout_t, Wkv_t, Wq_t, Wo_t, XN, gates, lds, gw, NGW, tid, lane, wave); }
    SEAM(0);
    if (IN(1)) {
        pg8::Gemm g{XN, Win_t, TPAD, 3072, 1024}; pg8::StaticOrder S; S.init(TPAD, 3072, G, bx);
        pg8::EpiBf16<0> E{PROJ, 3072, nullptr, 512, 512, 0.08838834764831845f};
        pg8::gemm_phase<pg8::EpiBf16<0>, pg8::StaticOrder, true, true>(lds + RING_OFF, g, S, E);
    }
    SEAM(1);
    if (IN(2)) { scan_seq(gates, 8, 4, 4, 8, Fm, gw, NGW, lane); }
    SEAM(2);
    if (IN(3)) { ph_mlstm_naive(PROJ, gates, Fm, m_g_out, XN, gw, NGW, lane); }
    SEAM(3);
    if (IN(4)) {
        pg8::Gemm g{XN, Wout_t, TPAD, 1024, 1024}; pg8::StaticOrder S; S.init(TPAD, 1024, G, bx);
        pg8::EpiResF32 E{x, meta, out, hmeta};
        pg8::gemm_phase<pg8::EpiResF32, pg8::StaticOrder, true, true>(lds + RING_OFF, g, S, E);
    }
    SEAM(4);
    if (IN(5)) { ph_norm_router(out, hmeta, TALL, norm_ffn, moe_w_group, moe_b_group, moe_w_router, moe_b_router, XN, tokp, ctl + CW_CNT, list, lds, gw, NGW, tid, lane); }
    SEAM(5);
    if (IN(6)) { ph_moe_naive(XN, tokp, ctl + CW_CNT, list, moe_w_gate, moe_w_up, moe_w_down, out, hmeta, lds, bx, G, tid); }
    SEAM(6);
    if (IN(7)) { ph_norm_kvq(out, hmeta, kv_norm, norm_mix + DM, kv_w, kv_b_f, XN, XQ, logf, lds, gw, NGW, tid, lane); }
    SEAM(7);
    if (IN(8)) {
        { pg8::Gemm g{XN, Wkv_t, TPAD, 2048, 1024}; pg8::StaticOrder S; S.init(TPAD, 2048, G, bx);
          pg8::EpiKV E{Kb, Vb};
          pg8::gemm_phase<pg8::EpiKV, pg8::StaticOrder, true, true>(lds + RING_OFF, g, S, E); }
        { pg8::Gemm g{XQ, Wq_t, TR, 1024, 1024}; pg8::StaticOrder S; S.init(TR, 1024, G, bx);
          pg8::EpiBf16<0> E{Qb, 1024, nullptr, 0, 0, 1.f};
          pg8::gemm_phase<pg8::EpiBf16<0>, pg8::StaticOrder, true, true>(lds + RING_OFF, g, S, E); }
    }
    SEAM(8);
    if (IN(9)) { ph_headnorm(Qb, Kb, f_q_norm, k_norm, gw, NGW, lane); scan_seq(logf, 16, 0, 16, 32, Fa, gw, NGW, lane); }
    SEAM(9);
    if (IN(10)) { ph_attn_naive(Qb, Kb, Vb, Fa, AO, gw, NGW, lane); }
    SEAM(10);
    if (IN(11)) {
        pg8::Gemm g{AO, Wo_t, TR, 1024, 1024}; pg8::StaticOrder S; S.init(TR, 1024, G, bx);
        pg8::EpiResF32 E{out, hmeta, out, hmeta};
        pg8::gemm_phase<pg8::EpiResF32, pg8::StaticOrder, true, true>(lds + RING_OFF, g, S, E);
    }
    SEAM(11);
    if (IN(12)) { ph_norm_router(out, hmeta, TR, norm_ffn + DM, moe_w_group + 4096, moe_b_group + 4, moe_w_router + 16384, moe_b_router + 16, XN, tokp, ctl + CW_CNT + 64, list, lds, gw, NGW, tid, lane); }
    SEAM(12);
    if (IN(13)) { ph_moe_naive(XN, tokp, ctl + CW_CNT + 64, list, moe_w_gate + (size_t)16 * 1024 * 256, moe_w_up + (size_t)16 * 1024 * 256, moe_w_down + (size_t)16 * 256 * 1024, out, hmeta, lds, bx, G, tid); }
#undef IN
#undef SEAM
}

extern "C" void kernel_launch(void* const* d_in, const int* in_sizes, int n_in, void* d_out, int out_size, void* d_ws, size_t ws_size, hipStream_t stream) {
    static int grid = 0;
    if (grid == 0) {
        int dev = 0, cus = 0, per_cu = 0;
        if (hipGetDevice(&dev) != hipSuccess || hipDeviceGetAttribute(&cus, hipDeviceAttributeMultiprocessorCount, dev) != hipSuccess) { fprintf(stderr, "kernel_launch: device query failed\n"); grid = -1; return; }
        if (hipFuncSetAttribute((const void*)trunk_fwd, hipFuncAttributeMaxDynamicSharedMemorySize, LDS_BYTES) != hipSuccess) { fprintf(stderr, "kernel_launch: hipFuncSetAttribute failed\n"); grid = -1; return; }
        if (hipOccupancyMaxActiveBlocksPerMultiprocessor(&per_cu, (const void*)trunk_fwd, NWAVES * 64, LDS_BYTES) != hipSuccess || per_cu < 1)
            fprintf(stderr, "kernel_launch: note: occupancy query reports %d workgroups per CU\n", per_cu);
        (void)hipGetLastError();
        grid = cus;
    }
    if (grid < 0) return;
    if (hipMemsetAsync((char*)d_ws + WS_CTL, 0, CTL_ZERO_BYTES, stream) != hipSuccess) { fprintf(stderr, "kernel_launch: memset failed\n"); return; }
    Args a{};
    for (int i = 0; i < 22; ++i) a.in[i] = (const float*)d_in[i];
    a.out = (float*)d_out; a.ws = (unsigned char*)d_ws;
    if (N_LAUNCHES == 1) { a.ph_lo = 0; a.ph_hi = NPHASE; a.li = 0; hipLaunchKernelGGL(trunk_fwd, dim3(grid), dim3(NWAVES * 64), LDS_BYTES, stream, a); }
    else for (int li = 0; li < NPHASE; ++li) { a.ph_lo = li; a.ph_hi = li + 1; a.li = li; hipLaunchKernelGGL(trunk_fwd, dim3(grid), dim3(NWAVES * 64), LDS_BYTES, stream, a); }
    const hipError_t le = hipPeekAtLastError();
    if (le != hipSuccess) fprintf(stderr, "kernel_launch: launch failed: %s\n", hipGetErrorName(le));
}
```

```cpp
#include <hip/hip_runtime.h>
#include <cstdio>
#include <cstdint>
namespace pg8 {
#define PG8_LAS __attribute__((address_space(3)))
typedef unsigned short bf16_t;
typedef short bf16x8 __attribute__((ext_vector_type(8)));
typedef float f32x4 __attribute__((ext_vector_type(4)));
typedef unsigned u32x4 __attribute__((ext_vector_type(4)));
constexpr int BM = 256, BK = 64, HALF = 128, HTB = HALF * BK * 2  , STAGE_BYTES = 8 * HTB, NXCD = 8, WGM = 8;

__host__ __device__ __forceinline__ int lds_byte(int r, int c) { const int st = (r >> 4) * 2 + (c >> 5), rr = r & 15, cc = c & 31, ob = rr * 64 + cc * 2; return st * 1024 + (ob ^ (((ob >> 9) & 1) << 5)); }
__host__ __device__ __forceinline__ void stage_rc(int b, int& R, int& C) { const int st = b / 1024, sb = b % 1024, swz = sb ^ (((sb >> 9) & 1) << 5); R = (st >> 1) * 16 + swz / 64; C = (st & 1) * 32 + (swz % 64) / 2; }
__host__ __device__ __forceinline__ int perm32(int rho) { const int n = rho >> 4, i = rho & 15; return 8 * (i >> 2) + 4 * n + (i & 3); }

struct Unit { int pm, pn; };
struct Gemm { const bf16_t* A; const bf16_t* Bt; int M, N, K; };

struct StaticOrder {
    int nM, nN, nwg, G, c;
    __host__ __device__ void init(int M, int N, int G_, int c_) { nM = M / BM; nN = N / BM; nwg = nM * nN; G = G_; c = c_; }
    __host__ __device__ bool next(int i, Unit& u) const {
        const long L = (long)i * G + c; if (L >= nwg) return false;
        int wgid = (int)L; { const int q = nwg / NXCD, r = nwg % NXCD, xcd = wgid % NXCD, off = wgid / NXCD; wgid = (xcd < r ? xcd * (q + 1) : r * (q + 1) + (xcd - r) * q) + off; }
        const int nig = WGM * nN, gid = wgid / nig, fm = gid * WGM, gsz = (nM - fm) < WGM ? (nM - fm) : WGM;
        u.pm = fm + ((wgid % nig) % gsz); u.pn = (wgid % nig) / gsz; return true;
    }
    __device__ __forceinline__ void a_ready(const Unit&) const {}
    __device__ __forceinline__ void done(const Unit&) const {}
};

__device__ __forceinline__ unsigned cvt_pk_bf16(float lo, float hi) { unsigned r; asm volatile("v_cvt_pk_bf16_f32 %0, %1, %2" : "=v"(r) : "v"(lo), "v"(hi)); return r; }
typedef float f32x2 __attribute__((ext_vector_type(2)));
__device__ __forceinline__ f32x2 gelu_pk(f32x2 v) {
    const f32x2 av = __builtin_elementwise_abs(v), d = av * 0.2316418882f + 1.0f;
    f32x2 t; t.x = __builtin_amdgcn_rcpf(d.x); t.y = __builtin_amdgcn_rcpf(d.y);
    f32x2 q = t * 0.5307027145f + (-0.7265760135f); q = q * t + 0.7107068705f; q = q * t + (-0.142248368f); q = q * t + 0.127414796f; q = q * t;
    const f32x2 s = (v * v) * (-0.72134752044f);
    f32x2 e; e.x = __builtin_amdgcn_exp2f(s.x); e.y = __builtin_amdgcn_exp2f(s.y);
    const f32x2 m = v * (q * e), r = v - m;
    f32x2 o; o.x = v.x < 0.f ? m.x : r.x; o.y = v.y < 0.f ? m.y : r.y; return o;
}

template <int ACT  > struct EpiBf16 {
    static constexpr bool PERM = true, AFTER_DRAIN = false, HEADMAP = false; static_assert(ACT == 0 || ACT == 1, "EpiBf16: ACT is 0 (none) or 1 (gelu_pk)");
    bf16_t* O; int ldc; const float* bias; int split_cols; size_t split_stride; float scale0;
    __device__ __forceinline__ void operator()(const f32x4 (&acc)[2][2][4][2], const Unit& u, int wr, int wc, int fr, int fq) const {
        const int row0 = u.pm * BM + wr * 64 + fr; int colt = u.pn * BM; bf16_t* base = O;
        float sc = 1.f; if (split_cols) { const int t = colt / split_cols; base += (size_t)t * split_stride; colt -= t * split_cols; if (t == 0) sc = scale0; }
        const int col0 = colt + wc * 32 + 8 * fq, bcol0 = u.pn * BM + wc * 32 + 8 * fq;
        f32x4 bv[2][2];
#pragma unroll
        for (int bj = 0; bj < 2; ++bj)
#pragma unroll
            for (int n = 0; n < 2; ++n) bv[bj][n] = bias ? *(const f32x4*)(bias + bcol0 + bj * HALF + 4 * n) : (f32x4){0.f, 0.f, 0.f, 0.f};
#pragma unroll
        for (int ai = 0; ai < 2; ++ai)
#pragma unroll
            for (int m = 0; m < 4; ++m) { bf16_t* rowp = base + (size_t)(row0 + ai * HALF + m * 16) * ldc + col0;
#pragma unroll
                for (int bj = 0; bj < 2; ++bj) { f32x4 v0 = acc[ai][bj][m][0] + bv[bj][0], v1 = acc[ai][bj][m][1] + bv[bj][1];
                    if (ACT == 1) { f32x2 a = gelu_pk((f32x2){v0[0], v0[1]}), b = gelu_pk((f32x2){v0[2], v0[3]}), c = gelu_pk((f32x2){v1[0], v1[1]}), d = gelu_pk((f32x2){v1[2], v1[3]});
                        v0 = (f32x4){a.x, a.y, b.x, b.y}; v1 = (f32x4){c.x, c.y, d.x, d.y}; }
                    v0 = v0 * sc; v1 = v1 * sc; u32x4 w; w.x = cvt_pk_bf16(v0[0], v0[1]); w.y = cvt_pk_bf16(v0[2], v0[3]); w.z = cvt_pk_bf16(v1[0], v1[1]); w.w = cvt_pk_bf16(v1[2], v1[3]);
                    *(u32x4*)(rowp + bj * HALF) = w; } }
    }
};
constexpr int X_TR = 16384, X_TALL = 16400, X_SEQ = 8192, X_KVROWS = 8256;
constexpr size_t X_Q_TO_RS = (size_t)(158 - 19) << 20;
__device__ __forceinline__ float xbl(unsigned u) { return __uint_as_float(u << 16); }
__device__ __forceinline__ float xbh(unsigned u) { return __uint_as_float(u & 0xffff0000u); }
template <bool BASE_BF16> struct EpiResB {
    static constexpr bool PERM = true, AFTER_DRAIN = false, HEADMAP = false;
    const void* base; bf16_t* H;
    __device__ __forceinline__ void operator()(const f32x4 (&acc)[2][2][4][2], const Unit& u, int wr, int wc, int fr, int fq) const {
        const int col0 = u.pn * BM + wc * 32 + 8 * fq;
        constexpr int MB = BASE_BF16 ? 4 : 2;
#pragma unroll
        for (int ai = 0; ai < 2; ++ai)
#pragma unroll
            for (int m0 = 0; m0 < 4; m0 += MB) {
                f32x4 b0[MB][2], b1[MB][2];
#pragma unroll
                for (int mm = 0; mm < MB; ++mm)
#pragma unroll
                    for (int bj = 0; bj < 2; ++bj) { const size_t ro = (size_t)(u.pm * BM + ai * HALF + wr * 64 + (m0 + mm) * 16 + fr) * 1024 + col0 + bj * HALF;
                        if (BASE_BF16) { const u32x4 raw = *(const u32x4*)((const bf16_t*)base + ro); b0[mm][bj] = (f32x4){xbl(raw.x), xbh(raw.x), xbl(raw.y), xbh(raw.y)}; b1[mm][bj] = (f32x4){xbl(raw.z), xbh(raw.z), xbl(raw.w), xbh(raw.w)}; }
                        else { b0[mm][bj] = *(const f32x4*)((const float*)base + ro); b1[mm][bj] = *(const f32x4*)((const float*)base + ro + 4); } }
#pragma unroll
                for (int mm = 0; mm < MB; ++mm)
#pragma unroll
                    for (int bj = 0; bj < 2; ++bj) { const size_t ro = (size_t)(u.pm * BM + ai * HALF + wr * 64 + (m0 + mm) * 16 + fr) * 1024 + col0 + bj * HALF;
                        const f32x4 v0 = acc[ai][bj][m0 + mm][0] + b0[mm][bj], v1 = acc[ai][bj][m0 + mm][1] + b1[mm][bj];
                        u32x4 w; w.x = cvt_pk_bf16(v0[0], v0[1]); w.y = cvt_pk_bf16(v0[2], v0[3]); w.z = cvt_pk_bf16(v1[0], v1[1]); w.w = cvt_pk_bf16(v1[2], v1[3]);
                        *(u32x4*)(H + ro) = w; }
            }
    }
};
struct EpiKV {
    static constexpr bool PERM = true, AFTER_DRAIN = false, HEADMAP = false;
    bf16_t* Kb; bf16_t* Vb;
    __device__ __forceinline__ void operator()(const f32x4 (&acc)[2][2][4][2], const Unit& u, int wr, int wc, int fr, int fq) const {
        const int row0 = u.pm * BM + wr * 64 + fr; int colt = u.pn * BM; bf16_t* base = Kb;
        if (colt >= 1024) { base = Vb; colt -= 1024; }
        const int col0 = colt + wc * 32 + 8 * fq;
#pragma unroll
        for (int ai = 0; ai < 2; ++ai)
#pragma unroll
            for (int m = 0; m < 4; ++m) {
                const int r = row0 + ai * HALF + m * 16;
                if (r >= X_TALL) continue;
                size_t d0, d1; bool two = false;
                if (r < X_TR) { d0 = (size_t)(r >> 13) * X_KVROWS + 64 + (r & (X_SEQ - 1)); d1 = d0; }
                else { d0 = (size_t)(r - X_TR); d1 = d0 + X_KVROWS; two = true; }
#pragma unroll
                for (int bj = 0; bj < 2; ++bj) { const f32x4 v0 = acc[ai][bj][m][0], v1 = acc[ai][bj][m][1];
                    u32x4 w; w.x = cvt_pk_bf16(v0[0], v0[1]); w.y = cvt_pk_bf16(v0[2], v0[3]); w.z = cvt_pk_bf16(v1[0], v1[1]); w.w = cvt_pk_bf16(v1[2], v1[3]);
                    *(u32x4*)(base + d0 * 1024 + col0 + bj * HALF) = w;
                    if (two) *(u32x4*)(base + d1 * 1024 + col0 + bj * HALF) = w; }
            }
    }
};

struct EpiKVN {
    static constexpr bool PERM = true, AFTER_DRAIN = false, HEADMAP = true;
    bf16_t* Kb; bf16_t* Vb; const float* gk; const float* rs;
    __device__ __forceinline__ void operator()(const f32x4 (&acc)[2][2][4][2], const Unit& u, int wr, int wc, int fr, int fq) const {
        const int row0 = u.pm * BM + wr * 64 + fr; int colt = u.pn * BM; bf16_t* base = Kb; const bool isK = colt < 1024;
        if (!isK) { base = Vb; colt -= 1024; }
        const int col0 = colt + wc * 64 + 8 * fq;
        f32x4 gv[2][2];
#pragma unroll
        for (int bj = 0; bj < 2; ++bj)
#pragma unroll
            for (int n = 0; n < 2; ++n) gv[bj][n] = isK ? *(const f32x4*)(gk + 32 * bj + 8 * fq + 4 * n) : (f32x4){1.f, 1.f, 1.f, 1.f};
        float rsa[2][4];
#pragma unroll
        for (int ai = 0; ai < 2; ++ai)
#pragma unroll
            for (int m = 0; m < 4; ++m) rsa[ai][m] = rs[row0 + ai * HALF + m * 16];
#pragma unroll
        for (int ai = 0; ai < 2; ++ai)
#pragma unroll
            for (int m = 0; m < 4; ++m) {
                const int r = row0 + ai * HALF + m * 16;
                float rstd = rsa[ai][m];
                if (isK) { float ss = 0.f;
#pragma unroll
                    for (int bj = 0; bj < 2; ++bj)
#pragma unroll
                        for (int n = 0; n < 2; ++n) { const f32x4 v = acc[ai][bj][m][n]; ss += (v[0] * v[0] + v[1] * v[1]) + (v[2] * v[2] + v[3] * v[3]); }
                    ss += __shfl_xor(ss, 16); ss += __shfl_xor(ss, 32);
                    rstd = rstd * rsqrtf(ss * (rstd * rstd * (1.f / 64.f)) + 1e-6f); }
                if (r >= X_TALL) continue;
                size_t d0, d1; bool two = false;
                if (r < X_TR) { d0 = (size_t)(r >> 13) * X_KVROWS + 64 + (r & (X_SEQ - 1)); d1 = d0; }
                else { d0 = (size_t)(r - X_TR); d1 = d0 + X_KVROWS; two = true; }
#pragma unroll
                for (int bj = 0; bj < 2; ++bj) { const f32x4 v0 = acc[ai][bj][m][0] * rstd * gv[bj][0], v1 = acc[ai][bj][m][1] * rstd * gv[bj][1];
                    u32x4 w; w.x = cvt_pk_bf16(v0[0], v0[1]); w.y = cvt_pk_bf16(v0[2], v0[3]); w.z = cvt_pk_bf16(v1[0], v1[1]); w.w = cvt_pk_bf16(v1[2], v1[3]);
                    *(u32x4*)(base + d0 * 1024 + col0 + bj * 32) = w;
                    if (two) *(u32x4*)(base + d1 * 1024 + col0 + bj * 32) = w; }
            }
    }
};
struct EpiQN {
    static constexpr bool PERM = true, AFTER_DRAIN = false, HEADMAP = true;
    bf16_t* Qb; const float* gq; float scale;
    __device__ __forceinline__ void operator()(const f32x4 (&acc)[2][2][4][2], const Unit& u, int wr, int wc, int fr, int fq) const {
        const int row0 = u.pm * BM + wr * 64 + fr; const int col0 = u.pn * BM + wc * 64 + 8 * fq; const float* rs = (const float*)((const char*)Qb - X_Q_TO_RS);
        f32x4 gv[2][2];
#pragma unroll
        for (int bj = 0; bj < 2; ++bj)
#pragma unroll
            for (int n = 0; n < 2; ++n) gv[bj][n] = *(const f32x4*)(gq + 32 * bj + 8 * fq + 4 * n) * scale;
        float rsa[2][4];
#pragma unroll
        for (int ai = 0; ai < 2; ++ai)
#pragma unroll
            for (int m = 0; m < 4; ++m) rsa[ai][m] = rs[row0 + ai * HALF + m * 16];
#pragma unroll
        for (int ai = 0; ai < 2; ++ai)
#pragma unroll
            for (int m = 0; m < 4; ++m) {
                const int r = row0 + ai * HALF + m * 16;
                float ss = 0.f;
#pragma unroll
                for (int bj = 0; bj < 2; ++bj)
#pragma unroll
                    for (int n = 0; n < 2; ++n) { const f32x4 v = acc[ai][bj][m][n]; ss += (v[0] * v[0] + v[1] * v[1]) + (v[2] * v[2] + v[3] * v[3]); }
                ss += __shfl_xor(ss, 16); ss += __shfl_xor(ss, 32);
                const float rsv = rsa[ai][m]; const float rstd = rsv * rsqrtf(ss * (rsv * rsv * (1.f / 64.f)) + 1e-6f);
#pragma unroll
                for (int bj = 0; bj < 2; ++bj) { const f32x4 v0 = acc[ai][bj][m][0] * rstd * gv[bj][0], v1 = acc[ai][bj][m][1] * rstd * gv[bj][1];
                    u32x4 w; w.x = cvt_pk_bf16(v0[0], v0[1]); w.y = cvt_pk_bf16(v0[2], v0[3]); w.z = cvt_pk_bf16(v1[0], v1[1]); w.w = cvt_pk_bf16(v1[2], v1[3]);
                    *(u32x4*)(Qb + (size_t)r * 1024 + col0 + bj * 32) = w; }
            }
    }
};

struct Unit2 { int mt, nv, aux, roff, bkt; };
struct Gemm2 { const char* A; int K, ldb; };
constexpr int MOE_NB = 24, MOE_CAP = 16400;
__device__ __forceinline__ void moe_pair(int pi, int& lo, int& hi) { lo = pi < 3 ? 0 : (pi < 5 ? 1 : 2); hi = pi < 3 ? pi + 1 : (pi < 5 ? pi - 1 : 3); }
template <int WHICH> struct MoeSched {
    const PG8_LAS int* tbl;
    const int* list; const char* W; int G, c;
    unsigned* rdy;
    __device__ __forceinline__ bool next(int i, Unit2& u) const {
        const int mtot = __builtin_amdgcn_readfirstlane(tbl[60]);
        int id;
        if (WHICH == 1) id = i * G + c;
        else { int nl = 4 * mtot - G; nl = nl > 0 ? nl : 0; const int nf = G - nl; if (c < nl) return false; id = (c - nl) + i * nf; }
        const int mt = id >> 2;
        if (mt >= mtot) return false;
        const int pk = __builtin_amdgcn_readfirstlane(tbl[64 + mt]), b = pk >> 16, t0 = pk & 0xffff;
        u.mt = __builtin_amdgcn_readfirstlane(mt); u.aux = __builtin_amdgcn_readfirstlane(id & 3); u.bkt = b; const int rem = __builtin_amdgcn_readfirstlane(tbl[32 + b]) - t0 * 256; u.nv = rem < 256 ? rem : 256; u.roff = b * MOE_CAP + t0 * 256;
        return true;
    }
    __device__ __forceinline__ void a_ready(const Unit2& u) const {
        if (WHICH == 2) {
            if (threadIdx.x < 64) {
                unsigned spins = 0;
                while ((unsigned)__builtin_amdgcn_readfirstlane(__hip_atomic_load(rdy + 64 * u.mt, __ATOMIC_RELAXED, __HIP_MEMORY_SCOPE_AGENT)) < 32u) { __builtin_amdgcn_s_sleep(2); if (++spins > (1u << 22)) break; }
                __builtin_amdgcn_fence(__ATOMIC_ACQUIRE, "agent");
                asm volatile("s_waitcnt vmcnt(0)" ::: "memory");
            }
            asm volatile("" ::: "memory"); __builtin_amdgcn_s_barrier(); asm volatile("" ::: "memory");
        }
    }
    __device__ __forceinline__ void done(const Unit2& u) const {
        if (WHICH == 1) {
            asm volatile("s_waitcnt vmcnt(0)" ::: "memory");
            if ((threadIdx.x & 63) == 0) __hip_atomic_fetch_add(rdy + 64 * u.mt, 1u, __ATOMIC_RELAXED, __HIP_MEMORY_SCOPE_AGENT);
        }
    }
    __device__ __forceinline__ const char* b_base(const Unit2& u) const {
        const int grp = u.bkt / 6, pi = u.bkt - grp * 6; int lo, hi; moe_pair(pi, lo, hi);
        if (WHICH == 1) { const int sw = (pi == 2) ? 1 : 0; const int e = grp * 4 + (((u.aux >> 1) ^ sw) ? hi : lo); return W + (size_t)(e * 2 + (u.aux & 1)) * (256 * 1024 * 2); }
        const int blk = pi == 0 ? 0 : (pi == 1 ? 4 : (pi == 2 ? 3 : (pi == 3 ? 1 : (pi == 4 ? 6 : 2))));
        return W + (size_t)u.aux * ((size_t)256 * 8192 * 2) + (size_t)(grp * 8 + blk) * 512;
    }
    __device__ __forceinline__ void a_offs(const Unit2& u, int tid, unsigned (&v0)[2], unsigned (&v1)[2]) const {
#pragma unroll
        for (int i = 0; i < 2; ++i) { int R, C; stage_rc(tid * 16 + i * 8192, R, C);
            if (WHICH == 1) { int r0 = R, r1 = 128 + R; r0 = r0 < u.nv ? r0 : u.nv - 1; r1 = r1 < u.nv ? r1 : u.nv - 1;
                v0[i] = (unsigned)(list[u.roff + r0] * 1024 + C) * 2u; v1[i] = (unsigned)(list[u.roff + r1] * 1024 + C) * 2u; }
            else { v0[i] = (unsigned)((u.mt * 256 + R) * 512 + C) * 2u; v1[i] = (unsigned)((u.mt * 256 + 128 + R) * 512 + C) * 2u; } }
    }
};
struct EpiMoe1 {
    static constexpr bool PERM = true, AFTER_DRAIN = false, HEADMAP = false;
    bf16_t* ACT; const float* LP;
    __device__ __forceinline__ void operator()(const f32x4 (&acc)[2][2][4][2], const Unit2& u, int wr, int wc, int fr, int fq) const {
        const int slot = u.aux >> 1, col0 = slot * 256 + (u.aux & 1) * 128 + wc * 32 + 8 * fq; const int sw = (u.bkt % 6 == 2) ? 1 : 0;
        float pr[2][4], rsv[2][4];
#pragma unroll
        for (int ai = 0; ai < 2; ++ai)
#pragma unroll
            for (int m = 0; m < 4; ++m) { const int rl = ai * HALF + wr * 64 + m * 16 + fr; const int rc = rl < u.nv ? rl : u.nv - 1;
                const float* lp = LP + (size_t)(u.roff + rc) * 4; pr[ai][m] = lp[slot ^ sw]; rsv[ai][m] = lp[2]; }
        const int nai = u.nv > 128 ? 2 : 1;
#pragma unroll
        for (int ai = 0; ai < 2; ++ai) if (ai < nai)
#pragma unroll
            for (int m = 0; m < 4; ++m) {
                const int rl = ai * HALF + wr * 64 + m * 16 + fr;
                const float p = pr[ai][m], rs1 = rsv[ai][m];
                const f32x4 g0 = acc[ai][0][m][0] * rs1, g1 = acc[ai][0][m][1] * rs1, u0 = acc[ai][1][m][0], u1 = acc[ai][1][m][1];
                f32x4 a0, a1;
#pragma unroll
                for (int i = 0; i < 4; ++i) { a0[i] = g0[i] * __builtin_amdgcn_rcpf(1.f + __expf(-g0[i])) * u0[i] * p; a1[i] = g1[i] * __builtin_amdgcn_rcpf(1.f + __expf(-g1[i])) * u1[i] * p; }
                u32x4 w; w.x = cvt_pk_bf16(a0[0], a0[1]); w.y = cvt_pk_bf16(a0[2], a0[3]); w.z = cvt_pk_bf16(a1[0], a1[1]); w.w = cvt_pk_bf16(a1[2], a1[3]);
                { const bf16_t* dst = ACT + (size_t)(u.mt * 256 + rl) * 512 + col0; asm volatile("global_store_dwordx4 %0, %1, off sc1\n\ts_nop 1" :: "v"(dst), "v"(w) : "memory"); }
            }
    }
};
template <bool FINAL> struct EpiMoe2R {
    static constexpr bool PERM = true, AFTER_DRAIN = false, HEADMAP = false;
    const bf16_t* Hin; void* dst; const int* list;
    __device__ __forceinline__ void operator()(const f32x4 (&acc)[2][2][4][2], const Unit2& u, int wr, int wc, int fr, int fq) const {
        const int col0 = u.aux * BM + wc * 32 + 8 * fq;
        int tok[2][4];
#pragma unroll
        for (int ai = 0; ai < 2; ++ai)
#pragma unroll
            for (int m = 0; m < 4; ++m) { const int rl = ai * HALF + wr * 64 + m * 16 + fr; tok[ai][m] = list[u.roff + (rl < u.nv ? rl : 0)]; }
#pragma unroll
        for (int ai = 0; ai < 2; ++ai) {
            u32x4 raw[4][2];
#pragma unroll
            for (int m = 0; m < 4; ++m)
#pragma unroll
                for (int bj = 0; bj < 2; ++bj) raw[m][bj] = *(const u32x4*)(Hin + (size_t)tok[ai][m] * 1024 + col0 + bj * HALF);
#pragma unroll
            for (int m = 0; m < 4; ++m) {
                const int rl = ai * HALF + wr * 64 + m * 16 + fr;
                if (rl < u.nv) {
                    const size_t ro = (size_t)tok[ai][m] * 1024 + col0;
#pragma unroll
                    for (int bj = 0; bj < 2; ++bj) { const u32x4 rw = raw[m][bj];
                        const f32x4 v0 = acc[ai][bj][m][0] + (f32x4){xbl(rw.x), xbh(rw.x), xbl(rw.y), xbh(rw.y)}, v1 = acc[ai][bj][m][1] + (f32x4){xbl(rw.z), xbh(rw.z), xbl(rw.w), xbh(rw.w)};
                        if (FINAL) { *(f32x4*)((float*)dst + ro + bj * HALF) = v0; *(f32x4*)((float*)dst + ro + bj * HALF + 4) = v1; }
                        else { u32x4 w; w.x = cvt_pk_bf16(v0[0], v0[1]); w.y = cvt_pk_bf16(v0[2], v0[3]); w.z = cvt_pk_bf16(v1[0], v1[1]); w.w = cvt_pk_bf16(v1[2], v1[3]);
                            *(u32x4*)((bf16_t*)dst + ro + bj * HALF) = w; } }
                }
            }
        }
    }
};
template <class Epi, class Sched, bool ALIGN_EPI = false, bool SP2 = false>
__device__ __forceinline__ void gemm_phase(PG8_LAS unsigned char* lds, const Gemm g, const Sched& S, const Epi& E) {
    const int tid = threadIdx.x, wid = __builtin_amdgcn_readfirstlane(tid >> 6), lane = tid & 63, wr = wid >> 2, wc = wid & 3, fr = lane & 15, fq = lane >> 4;
    const int K = g.K, nt = K / BK;
    unsigned voffA[2], voffB[2];
#pragma unroll
    for (int i = 0; i < 2; ++i) { int R, C; stage_rc(tid * 16 + i * 8192, R, C); const int Rb = Epi::HEADMAP ? (2 * (R & ~31) + perm32(R & 31)) : (Epi::PERM ? ((R & ~31) + perm32(R & 31)) : R);
        voffA[i] = (unsigned)(R * K + C) * 2u; voffB[i] = (unsigned)(Rb * K + C) * 2u; }
    const size_t kstep = (size_t)(BK * 2);
    const size_t hstep = (size_t)HALF * K * 2;
    const size_t tstep = 2 * hstep;
    const size_t hstepB = Epi::HEADMAP ? (size_t)32 * K * 2 : hstep;
    const unsigned ldsw = (unsigned)wid * 1024u;
    const int aoff = lds_byte(wr * 64 + fr, fq * 8), boff = lds_byte(wc * 32 + fr, fq * 8);
#define PG8_SA(b, h) (((b) * 2 + (h)) * HTB)
#define PG8_SB(b, h) ((4 + (b) * 2 + (h)) * HTB)
#define PG8_STAGE(bufoff, gbase, voff) do { _Pragma("unroll") for (int _i = 0; _i < 2; ++_i) \
        __builtin_amdgcn_global_load_lds((const unsigned*)((const char*)(gbase) + (voff)[_i]), (PG8_LAS unsigned*)(lds + (bufoff) + ldsw + _i * 8192), 16, 0, 0); } while (0)
#define PG8_LDA(dst, b, h) do { _Pragma("unroll") for (int m = 0; m < 4; ++m) _Pragma("unroll") for (int k = 0; k < 2; ++k) dst[m][k] = *(const PG8_LAS bf16x8*)(lds + PG8_SA(b, h) + aoff + m * 2048 + k * 1024); } while (0)
#define PG8_LDB(dst, b, h) do { _Pragma("unroll") for (int n = 0; n < 2; ++n) _Pragma("unroll") for (int k = 0; k < 2; ++k) dst[n][k] = *(const PG8_LAS bf16x8*)(lds + PG8_SB(b, h) + boff + n * 2048 + k * 1024); } while (0)
#define PG8_MMA(ai, bj, At, Bt) do { __builtin_amdgcn_s_setprio(1); _Pragma("unroll") for (int m = 0; m < 4; ++m) _Pragma("unroll") for (int n = 0; n < 2; ++n) _Pragma("unroll") for (int k = 0; k < 2; ++k) \
        acc[ai][bj][m][n] = __builtin_amdgcn_mfma_f32_16x16x32_bf16(Bt[n][k], At[m][k], acc[ai][bj][m][n], 0, 0, 0); __builtin_amdgcn_s_setprio(0); } while (0)
#define PG8_WAIT_V(n) asm volatile("s_waitcnt vmcnt(" #n ")" ::: "memory")
#define PG8_WAIT_L(n) asm volatile("s_waitcnt lgkmcnt(" #n ")" ::: "memory")
#define PG8_BAR __builtin_amdgcn_s_barrier()
#define PG8_SCHED __builtin_amdgcn_sched_barrier(0)
    Unit cur, nxt; int ui = 0;
    if (!S.next(0, cur)) return;
    f32x4 acc[2][2][4][2];
#pragma unroll
    for (int a = 0; a < 2; ++a)
#pragma unroll
        for (int b = 0; b < 2; ++b)
#pragma unroll
            for (int m = 0; m < 4; ++m)
#pragma unroll
                for (int n = 0; n < 2; ++n) acc[a][b][m][n] = (f32x4){0.f, 0.f, 0.f, 0.f};
    bf16x8 At[4][2], B0[2][2], B1[2][2];
    const char* cA = (const char*)g.A + (size_t)cur.pm * tstep; const char* cB = (const char*)g.Bt + (size_t)cur.pn * tstep;
    S.a_ready(cur);
    if constexpr (SP2) {
        PG8_STAGE(PG8_SB(0, 0), cB, voffB); PG8_STAGE(PG8_SB(0, 1), cB + hstepB, voffB); PG8_STAGE(PG8_SA(0, 0), cA, voffA); PG8_STAGE(PG8_SA(0, 1), cA + hstep, voffA);
        if (wr == 1) PG8_BAR;
        PG8_WAIT_V(2); PG8_BAR;
        PG8_STAGE(PG8_SB(1, 0), cB + kstep, voffB); PG8_STAGE(PG8_SA(1, 0), cA + kstep, voffA); PG8_STAGE(PG8_SB(1, 1), cB + hstepB + kstep, voffB);
        PG8_WAIT_V(6); PG8_BAR;
    } else {
        PG8_STAGE(PG8_SB(0, 0), cB, voffB); PG8_STAGE(PG8_SA(0, 0), cA, voffA); PG8_STAGE(PG8_SB(0, 1), cB + hstepB, voffB); PG8_STAGE(PG8_SA(0, 1), cA + hstep, voffA);
        if (wr == 1) PG8_BAR;
        PG8_WAIT_V(4); PG8_BAR;
        PG8_STAGE(PG8_SB(1, 0), cB + kstep, voffB); PG8_STAGE(PG8_SA(1, 0), cA + kstep, voffA); PG8_STAGE(PG8_SB(1, 1), cB + hstepB + kstep, voffB);
        PG8_WAIT_V(6); PG8_BAR;
    }
    for (;;) {
        const bool has_next = S.next(ui + 1, nxt);
        const char* nA = has_next ? (const char*)g.A + (size_t)nxt.pm * tstep : cA; const char* nB = has_next ? (const char*)g.Bt + (size_t)nxt.pn * tstep : cB;
        for (int t = 0; t < nt; t += 2) {
            const bool last = (t == nt - 2);
            const char* a1 = cA + (size_t)(t + 1) * kstep;
            const char* a2 = last ? nA : cA + (size_t)(t + 2) * kstep; const char* b2 = last ? nB : cB + (size_t)(t + 2) * kstep;
            const char* a3 = a2 + kstep; const char* b3 = b2 + kstep;
            if (last && has_next) S.a_ready(nxt);
            if constexpr (SP2) {
            PG8_LDB(B0, 0, 0); PG8_LDB(B1, 0, 1); PG8_SCHED; PG8_LDA(At, 0, 0); PG8_STAGE(PG8_SA(1, 1), a1 + hstep, voffA);
            PG8_WAIT_V(8); PG8_WAIT_L(0); PG8_BAR; PG8_MMA(0, 0, At, B0); PG8_MMA(0, 1, At, B1); PG8_BAR; PG8_SCHED;
            PG8_LDA(At, 0, 1); PG8_STAGE(PG8_SB(0, 0), b2, voffB); PG8_STAGE(PG8_SB(0, 1), b2 + hstepB, voffB); PG8_STAGE(PG8_SA(0, 0), a2, voffA);
            PG8_WAIT_V(8); PG8_WAIT_L(0); PG8_BAR; PG8_MMA(1, 0, At, B0); PG8_MMA(1, 1, At, B1); PG8_BAR; PG8_SCHED;
            PG8_LDB(B0, 1, 0); PG8_LDB(B1, 1, 1); PG8_SCHED; PG8_LDA(At, 1, 0); PG8_STAGE(PG8_SA(0, 1), a2 + hstep, voffA);
            PG8_WAIT_V(8); PG8_WAIT_L(0); PG8_BAR; PG8_MMA(0, 0, At, B0); PG8_MMA(0, 1, At, B1); PG8_BAR; PG8_SCHED;
            PG8_LDA(At, 1, 1); PG8_STAGE(PG8_SB(1, 0), b3, voffB); PG8_STAGE(PG8_SB(1, 1), b3 + hstepB, voffB); PG8_STAGE(PG8_SA(1, 0), a3, voffA);
            PG8_WAIT_V(8); PG8_WAIT_L(0); PG8_BAR; PG8_MMA(1, 0, At, B0); PG8_MMA(1, 1, At, B1); PG8_BAR; PG8_SCHED;
            } else {
            PG8_LDB(B0, 0, 0); PG8_SCHED; PG8_LDA(At, 0, 0); PG8_STAGE(PG8_SA(1, 1), a1 + hstep, voffA);
            PG8_WAIT_L(8); PG8_BAR; PG8_WAIT_L(0); PG8_MMA(0, 0, At, B0); PG8_BAR; PG8_SCHED;
            PG8_LDB(B1, 0, 1); PG8_STAGE(PG8_SB(0, 0), b2, voffB);
            PG8_BAR; PG8_WAIT_L(0); PG8_MMA(0, 1, At, B1); PG8_BAR;
            PG8_LDA(At, 0, 1); PG8_STAGE(PG8_SA(0, 0), a2, voffA);
            PG8_BAR; PG8_WAIT_L(0); PG8_MMA(1, 0, At, B0); PG8_BAR; PG8_SCHED;
            PG8_STAGE(PG8_SB(0, 1), b2 + hstepB, voffB);
            PG8_WAIT_V(6); PG8_BAR; PG8_MMA(1, 1, At, B1); PG8_BAR;
            PG8_LDB(B0, 1, 0); PG8_SCHED; PG8_LDA(At, 1, 0); PG8_STAGE(PG8_SA(0, 1), a2 + hstep, voffA);
            PG8_WAIT_L(8); PG8_BAR; PG8_WAIT_L(0); PG8_MMA(0, 0, At, B0); PG8_BAR; PG8_SCHED;
            PG8_LDB(B1, 1, 1); PG8_STAGE(PG8_SB(1, 0), b3, voffB);
            PG8_BAR; PG8_WAIT_L(0); PG8_MMA(0, 1, At, B1); PG8_BAR;
            PG8_LDA(At, 1, 1); PG8_STAGE(PG8_SA(1, 0), a3, voffA);
            PG8_BAR; PG8_WAIT_L(0); PG8_MMA(1, 0, At, B0); PG8_BAR; PG8_SCHED;
            PG8_STAGE(PG8_SB(1, 1), b3 + hstepB, voffB);
            PG8_WAIT_V(6); PG8_BAR; PG8_MMA(1, 1, At, B1); PG8_BAR;
            }
        }
        if constexpr (ALIGN_EPI) { if (wr == 0) PG8_BAR; }
        if constexpr (!Epi::AFTER_DRAIN) { E(acc, cur, wr, wc, fr, fq); S.done(cur); }
        if (!has_next) break;
#pragma unroll
        for (int a = 0; a < 2; ++a)
#pragma unroll
            for (int b = 0; b < 2; ++b)
#pragma unroll
                for (int m = 0; m < 4; ++m)
#pragma unroll
                    for (int n = 0; n < 2; ++n) acc[a][b][m][n] = (f32x4){0.f, 0.f, 0.f, 0.f};
        cur = nxt; cA = nA; cB = nB; ++ui;
        if constexpr (ALIGN_EPI) { if (wr == 1) PG8_BAR; }
    }
    PG8_WAIT_V(0);
    if constexpr (!ALIGN_EPI) { if (wr == 0) PG8_BAR; }
    PG8_BAR;
    if constexpr (Epi::AFTER_DRAIN) { E.fused(acc, cur, wr, wc, fr, fq, lds, wid, lane); S.done(cur); }
#undef PG8_SA
#undef PG8_SB
#undef PG8_STAGE
#undef PG8_LDA
#undef PG8_LDB
#undef PG8_MMA
#undef PG8_WAIT_V
#undef PG8_WAIT_L
#undef PG8_BAR
#undef PG8_SCHED
}
}
namespace pg8 {
template <class Epi, class Sched>
__device__ __forceinline__ void gemm_phase2(PG8_LAS unsigned char* lds, PG8_LAS unsigned* offs  , const Gemm2 g, const Sched& S, const Epi& E) {
    const int tid = threadIdx.x, wid = __builtin_amdgcn_readfirstlane(tid >> 6), lane = tid & 63, wr = wid >> 2, wc = wid & 3, fr = lane & 15, fq = lane >> 4;
    const int K = g.K, nt = K / BK;
    unsigned voffB[2];
#pragma unroll
    for (int i = 0; i < 2; ++i) { int R, C; stage_rc(tid * 16 + i * 8192, R, C); const int Rb = Epi::PERM ? ((R & ~31) + perm32(R & 31)) : R;
        voffB[i] = (unsigned)(Rb * g.ldb + C) * 2u; }
    const size_t kstep = (size_t)(BK * 2);
    const size_t hstepB = (size_t)HALF * g.ldb * 2;
    const unsigned ldsw = (unsigned)wid * 1024u;
    const int aoff = lds_byte(wr * 64 + fr, fq * 8), boff = lds_byte(wc * 32 + fr, fq * 8);
#define PG8_SA(b, h) (((b) * 2 + (h)) * HTB)
#define PG8_SB(b, h) ((4 + (b) * 2 + (h)) * HTB)
#define PG8_STAGE(bufoff, gbase, voff) do { _Pragma("unroll") for (int _i = 0; _i < 2; ++_i) \
        __builtin_amdgcn_global_load_lds((const unsigned*)((const char*)(gbase) + (voff)[_i]), (PG8_LAS unsigned*)(lds + (bufoff) + ldsw + _i * 8192), 16, 0, 0); } while (0)
#define PG8_LDA(dst, b, h) do { _Pragma("unroll") for (int m = 0; m < 4; ++m) _Pragma("unroll") for (int k = 0; k < 2; ++k) dst[m][k] = *(const PG8_LAS bf16x8*)(lds + PG8_SA(b, h) + aoff + m * 2048 + k * 1024); } while (0)
#define PG8_LDB(dst, b, h) do { _Pragma("unroll") for (int n = 0; n < 2; ++n) _Pragma("unroll") for (int k = 0; k < 2; ++k) dst[n][k] = *(const PG8_LAS bf16x8*)(lds + PG8_SB(b, h) + boff + n * 2048 + k * 1024); } while (0)
#define PG8_MMA(ai, bj, At, Bt) do { __builtin_amdgcn_s_setprio(1); _Pragma("unroll") for (int m = 0; m < 4; ++m) _Pragma("unroll") for (int n = 0; n < 2; ++n) _Pragma("unroll") for (int k = 0; k < 2; ++k) \
        acc[ai][bj][m][n] = __builtin_amdgcn_mfma_f32_16x16x32_bf16(Bt[n][k], At[m][k], acc[ai][bj][m][n], 0, 0, 0); __builtin_amdgcn_s_setprio(0); } while (0)
#define PG8_WAIT_V(n) asm volatile("s_waitcnt vmcnt(" #n ")" ::: "memory")
#define PG8_WAIT_L(n) asm volatile("s_waitcnt lgkmcnt(" #n ")" ::: "memory")
#define PG8_BAR __builtin_amdgcn_s_barrier()
#define PG8_SCHED __builtin_amdgcn_sched_barrier(0)
#define PG8_KLOOP(FULL) do { \
        for (int t = 0; t < nt; t += 2) { \
            const bool last = (t == nt - 2); \
            if (last && has_next) S.a_ready(nxt); \
            const char* a1 = cA + (size_t)(t + 1) * kstep; \
            const char* a2 = last ? cA : cA + (size_t)(t + 2) * kstep; const char* a3 = a2 + kstep; \
            const char* b2 = last ? nB : cB + (size_t)(t + 2) * kstep; const char* b3 = b2 + kstep; \
            const int so_x = last ? so_nxt : so_cur; \
            PG8_LDB(B0, 0, 0); PG8_LDB(B1, 0, 1); PG8_SCHED; PG8_LDA(At, 0, 0); PG8_STAGE_A(PG8_SA(1, 1), a1, 1, so_cur); \
            PG8_WAIT_V(8); PG8_WAIT_L(0); PG8_BAR; PG8_MMA(0, 0, At, B0); PG8_MMA(0, 1, At, B1); PG8_BAR; PG8_SCHED; \
            if (FULL) { PG8_LDA(At, 0, 1); } PG8_STAGE(PG8_SB(0, 0), b2, voffB); PG8_STAGE(PG8_SB(0, 1), b2 + hstepB, voffB); PG8_STAGE_A(PG8_SA(0, 0), a2, 0, so_x); \
            PG8_WAIT_V(8); PG8_WAIT_L(0); PG8_BAR; if (FULL) { PG8_MMA(1, 0, At, B0); PG8_MMA(1, 1, At, B1); } PG8_BAR; PG8_SCHED; \
            PG8_LDB(B0, 1, 0); PG8_LDB(B1, 1, 1); PG8_SCHED; PG8_LDA(At, 1, 0); PG8_STAGE_A(PG8_SA(0, 1), a2, 1, so_x); \
            PG8_WAIT_V(8); PG8_WAIT_L(0); PG8_BAR; PG8_MMA(0, 0, At, B0); PG8_MMA(0, 1, At, B1); PG8_BAR; PG8_SCHED; \
            if (FULL) { PG8_LDA(At, 1, 1); } PG8_STAGE(PG8_SB(1, 0), b3, voffB); PG8_STAGE(PG8_SB(1, 1), b3 + hstepB, voffB); PG8_STAGE_A(PG8_SA(1, 0), a3, 0, so_x); \
            PG8_WAIT_V(8); PG8_WAIT_L(0); PG8_BAR; if (FULL) { PG8_MMA(1, 0, At, B0); PG8_MMA(1, 1, At, B1); } PG8_BAR; PG8_SCHED; \
        } \
    } while (0)
    Unit2 cur, nxt; int ui = 0;
    if (!S.next(0, cur)) return;
    S.a_ready(cur);
    f32x4 acc[2][2][4][2];
#pragma unroll
    for (int a = 0; a < 2; ++a)
#pragma unroll
        for (int b = 0; b < 2; ++b)
#pragma unroll
            for (int m = 0; m < 4; ++m)
#pragma unroll
                for (int n = 0; n < 2; ++n) acc[a][b][m][n] = (f32x4){0.f, 0.f, 0.f, 0.f};
    bf16x8 At[4][2], B0[2][2], B1[2][2];
    PG8_LAS unsigned* myo = offs + 4 * tid;
    { unsigned v0[2], v1[2]; S.a_offs(cur, tid, v0, v1); myo[0] = v0[0]; myo[1] = v0[1]; myo[2] = v1[0]; myo[3] = v1[1]; }
    int so_cur = 0;
    const char* cA = g.A; const char* cB = S.b_base(cur);
#define PG8_STAGE_A(bufoff, gbase, h, so) do { const unsigned _o0 = myo[(so) + 2 * (h)], _o1 = myo[(so) + 2 * (h) + 1]; \
        __builtin_amdgcn_global_load_lds((const unsigned*)((const char*)(gbase) + _o0), (PG8_LAS unsigned*)(lds + (bufoff) + ldsw), 16, 0, 0); \
        __builtin_amdgcn_global_load_lds((const unsigned*)((const char*)(gbase) + _o1), (PG8_LAS unsigned*)(lds + (bufoff) + ldsw + 8192), 16, 0, 0); } while (0)
    PG8_STAGE(PG8_SB(0, 0), cB, voffB); PG8_STAGE(PG8_SB(0, 1), cB + hstepB, voffB); PG8_STAGE_A(PG8_SA(0, 0), cA, 0, 0); PG8_STAGE_A(PG8_SA(0, 1), cA, 1, 0);
    if (wr == 1) PG8_BAR;
    PG8_WAIT_V(2); PG8_BAR;
    PG8_STAGE(PG8_SB(1, 0), cB + kstep, voffB); PG8_STAGE_A(PG8_SA(1, 0), cA + kstep, 0, 0); PG8_STAGE(PG8_SB(1, 1), cB + hstepB + kstep, voffB);
    PG8_WAIT_V(6); PG8_BAR;
    for (;;) {
        const bool has_next = S.next(ui + 1, nxt);
        if (!has_next) nxt = cur;
        const char* nB = has_next ? S.b_base(nxt) : cB;
        const int so_nxt = has_next ? (so_cur ^ 2048) : so_cur;
        if (has_next) { unsigned n0[2], n1[2]; S.a_offs(nxt, tid, n0, n1); myo[so_nxt] = n0[0]; myo[so_nxt + 1] = n0[1]; myo[so_nxt + 2] = n1[0]; myo[so_nxt + 3] = n1[1]; }
        if (cur.nv > 128) PG8_KLOOP(1); else PG8_KLOOP(0);
        if (wr == 0) PG8_BAR;
        E(acc, cur, wr, wc, fr, fq);
        S.done(cur);
        if (!has_next) break;
#pragma unroll
        for (int a = 0; a < 2; ++a)
#pragma unroll
            for (int b = 0; b < 2; ++b)
#pragma unroll
                for (int m = 0; m < 4; ++m)
#pragma unroll
                    for (int n = 0; n < 2; ++n) acc[a][b][m][n] = (f32x4){0.f, 0.f, 0.f, 0.f};
        cur = nxt; cB = nB; ++ui; so_cur = so_nxt;
        if (wr == 1) PG8_BAR;
    }
    PG8_WAIT_V(0);
    PG8_BAR;
#undef PG8_KLOOP
#undef PG8_SA
#undef PG8_SB
#undef PG8_STAGE
#undef PG8_STAGE_A
#undef PG8_LDA
#undef PG8_LDB
#undef PG8_MMA
#undef PG8_WAIT_V
#undef PG8_WAIT_L
#undef PG8_BAR
#undef PG8_SCHED
}
}
#include <hip/hip_bf16.h>
#include <cmath>
namespace attn_body {
using bf16=__hip_bfloat16;
using bf16x8=__attribute__((ext_vector_type(8)))short;
using s16x4=__attribute__((ext_vector_type(4)))short;
using f32x16=__attribute__((ext_vector_type(16)))float;
using u32x4=__attribute__((ext_vector_type(4)))unsigned;
constexpr int BATCH=2,NHEAD=16,SEQ=8192,D=64,DM=NHEAD*D,KVR=8256;
constexpr int NW=8,QBLK=32,QB=QBLK*NW,KVBLK=64,NQB=SEQ/QB;
constexpr int ATTN_PITCH=DM, ATTN_UNIT_ROWS=QB;
__device__ __forceinline__ int crow(int r,int hi){return (r&3)+8*(r>>2)+4*hi;}
#define SBAR() __builtin_amdgcn_sched_barrier(0)
__device__ __forceinline__ void cmask(f32x16&p0,f32x16&p1,int jb,int qrel,int hi){
  const float NEG=-INFINITY; int kb=64*jb+4*hi;
  #pragma unroll
  for(int r=0;r<16;++r){int kv=kb+(r&3)+8*(r>>2); if(kv>qrel)p0[r]=NEG; if(kv+32>qrel)p1[r]=NEG;}
}

constexpr int NSLOT=3, SLOTB=8192;
constexpr int LDS_K=0, LDS_V=NSLOT*SLOTB, LDS_WS=2*NSLOT*SLOTB, LDS_OST=LDS_WS+NW*64*4, LDS_BYTES=LDS_OST+NW*4096;
constexpr float C2=0.125f*1.4426950408889634f;
__device__ __forceinline__ void glds16(const void*gsrc,unsigned lds_dst){unsigned keep;
  asm volatile("s_mov_b32 %0, m0\n\ts_mov_b32 m0, %2\n\ts_nop 0\n\tglobal_load_lds_dwordx4 %1, off\n\ts_mov_b32 m0, %0":"=&s"(keep):"v"(gsrc),"s"(lds_dst):"memory");}
__device__ __forceinline__ float max3f(float a,float b,float c){float r;asm("v_max3_f32 %0, %1, %2, %3":"=v"(r):"v"(a),"v"(b),"v"(c));return r;}
__device__ __forceinline__ float max2f(float a,float b){float r;asm("v_max_f32_e32 %0, %1, %2":"=v"(r):"v"(a),"v"(b));return r;}
__device__ __forceinline__ float fadd_s(float a,float b){float r;asm("v_add_f32_e32 %0, %1, %2":"=v"(r):"v"(a),"v"(b));return r;}
__device__ __forceinline__ float fsub_s(float a,float b){float r;asm("v_sub_f32_e32 %0, %1, %2":"=v"(r):"v"(a),"v"(b));return r;}
typedef float f32x2_t __attribute__((ext_vector_type(2))); typedef __bf16 bf16x2_t __attribute__((ext_vector_type(2)));
__device__ __forceinline__ unsigned cvtpk_s(float lo,float hi){f32x2_t v={lo,hi};bf16x2_t b=__builtin_convertvector(v,bf16x2_t);return __builtin_bit_cast(unsigned,b);}
#define WAIT_BAR(N) asm volatile("s_waitcnt vmcnt(" #N ") lgkmcnt(0)\n\ts_barrier":::"memory")

__device__ __forceinline__ void qkt(f32x16&p0,f32x16&p1,const char*Kslot,const bf16x8*qr,const f32x16&n0,const f32x16&n1,int r32,int hi){
  const char*kb=Kslot+hi*1024+r32*16;
  #pragma unroll
  for(int d0=0;d0<4;++d0){
    const bf16x8 b0=*reinterpret_cast<const bf16x8*>(kb+d0*2048);
    const bf16x8 b1=*reinterpret_cast<const bf16x8*>(kb+d0*2048+512);
    if(d0==0){p0=__builtin_amdgcn_mfma_f32_32x32x16_bf16(b0,qr[0],n0,0,0,0);p1=__builtin_amdgcn_mfma_f32_32x32x16_bf16(b1,qr[0],n1,0,0,0);}
    else{p0=__builtin_amdgcn_mfma_f32_32x32x16_bf16(b0,qr[d0],p0,0,0,0);p1=__builtin_amdgcn_mfma_f32_32x32x16_bf16(b1,qr[d0],p1,0,0,0);}}
}
typedef __attribute__((address_space(3))) const char* lds_cptr;
typedef short v4i16_t __attribute__((ext_vector_type(4)));
__device__ __forceinline__ void kload8(bf16x8*kf,lds_cptr kp){
  kf[0]=*(const __attribute__((address_space(3))) bf16x8*)(kp);      kf[1]=*(const __attribute__((address_space(3))) bf16x8*)(kp+512);
  kf[2]=*(const __attribute__((address_space(3))) bf16x8*)(kp+2048); kf[3]=*(const __attribute__((address_space(3))) bf16x8*)(kp+2560);
  kf[4]=*(const __attribute__((address_space(3))) bf16x8*)(kp+4096); kf[5]=*(const __attribute__((address_space(3))) bf16x8*)(kp+4608);
  kf[6]=*(const __attribute__((address_space(3))) bf16x8*)(kp+6144); kf[7]=*(const __attribute__((address_space(3))) bf16x8*)(kp+6656);
}
__device__ __forceinline__ void kload2(bf16x8*kf,lds_cptr kp,int j){ kf[2*j]=*(const __attribute__((address_space(3))) bf16x8*)(kp+j*2048); kf[2*j+1]=*(const __attribute__((address_space(3))) bf16x8*)(kp+j*2048+512); }
__device__ __forceinline__ s16x4 vtr(lds_cptr p){ return __builtin_bit_cast(s16x4,__builtin_amdgcn_ds_read_tr16_b64_v4i16((__attribute__((address_space(3))) v4i16_t*)p)); }
__device__ __forceinline__ float rowmax(const f32x16&p0,const f32x16&p1){
  float a=max3f(p0[0],p0[1],p1[0]),b=max3f(p0[2],p0[3],p1[1]);a=max3f(a,p1[2],p1[3]);
  #pragma unroll
  for(int r=4;r<16;r+=4){a=max3f(a,p0[r],p0[r+1]);b=max3f(b,p0[r+2],p0[r+3]);a=max3f(a,p1[r],p1[r+1]);b=max3f(b,p1[r+2],p1[r+3]);}
  const float m=max2f(a,b);
  auto rr=__builtin_amdgcn_permlane32_swap(__float_as_uint(m),__float_as_uint(m),false,false);
  return max2f(__uint_as_float(rr[0]),__uint_as_float(rr[1]));
}
__device__ __forceinline__ void pv(f32x16*o,int vb,bf16x8 pa0,bf16x8 pa1,bf16x8 pa2,bf16x8 pa3){
  #pragma unroll
  for(int d0=0;d0<2;++d0){s16x4 lo[4],hi[4];
    #pragma unroll
    for(int ks=0;ks<4;++ks){
      asm volatile("ds_read_b64_tr_b16 %0,%1 offset:%c2":"=&v"(lo[ks]):"v"(vb),"i"(d0*4096+ks*1024):"memory");
      asm volatile("ds_read_b64_tr_b16 %0,%1 offset:%c2":"=&v"(hi[ks]):"v"(vb),"i"(d0*4096+ks*1024+512):"memory");}
    asm volatile("s_waitcnt lgkmcnt(0)":::"memory");SBAR();
    #define PK(k) (bf16x8){lo[k][0],lo[k][1],lo[k][2],lo[k][3],hi[k][0],hi[k][1],hi[k][2],hi[k][3]}
    o[d0]=__builtin_amdgcn_mfma_f32_32x32x16_bf16(pa0,PK(0),o[d0],0,0,0);
    o[d0]=__builtin_amdgcn_mfma_f32_32x32x16_bf16(pa1,PK(1),o[d0],0,0,0);
    o[d0]=__builtin_amdgcn_mfma_f32_32x32x16_bf16(pa2,PK(2),o[d0],0,0,0);
    o[d0]=__builtin_amdgcn_mfma_f32_32x32x16_bf16(pa3,PK(3),o[d0],0,0,0);
    #undef PK
  }
}

#ifndef ATTN_STORE16
#define ATTN_STORE16(p,v) (*(u32x4*)(p)=(v))
#endif

__device__ __forceinline__ void attn_finish(const f32x16 (&o)[2],float l_reg,bf16*Ow,char*shm,int wid,int lane){
  const int r32=lane&31,hi=lane>>5; float*wsf=(float*)(shm+LDS_WS)+wid*64;
  {auto rr=__builtin_amdgcn_permlane32_swap(__float_as_uint(l_reg),__float_as_uint(l_reg),false,false);l_reg=__uint_as_float(rr[0])+__uint_as_float(rr[1]);}
  if(hi==0)wsf[32+r32]=l_reg;asm volatile("s_waitcnt lgkmcnt(0)":::"memory");
  float rli[16];
  #pragma unroll
  for(int r=0;r<16;++r)rli[r]=__builtin_amdgcn_rcpf(wsf[32+crow(r,hi)]);
  { bf16*stg=(bf16*)(shm+LDS_OST)+wid*2048;
    #pragma unroll
    for(int r=0;r<16;++r){const int orow=crow(r,hi);
      #pragma unroll
      for(int d0=0;d0<2;++d0)stg[orow*64+d0*32+r32]=__float2bfloat16(o[d0][r]*rli[r]);}
    asm volatile("s_waitcnt lgkmcnt(0)":::"memory");
    #pragma unroll
    for(int i=0;i<4;++i){const int row=i*8+(lane>>3),ch=lane&7; const u32x4 v=*(const u32x4*)(stg+row*64+ch*8); ATTN_STORE16(Ow+(long)row*DM+ch*8,v);} }
}
typedef float f32x4_t __attribute__((ext_vector_type(4)));
template<int THRL> __device__ __forceinline__ void attn_unit(int b,int h,int qb,const bf16*Q,const bf16*__restrict__ K,const bf16*__restrict__ V,bf16*O,char*shm,const __attribute__((address_space(3))) float*fk,const __attribute__((address_space(3))) float*fq,int tile0,int NT,bool band,float*pdump){
  const int tid=threadIdx.x,lane=tid&63,r32=lane&31,hi=lane>>5; const int wid=__builtin_amdgcn_readfirstlane(tid>>6);
  const long rowbase=(long)b*SEQ, kvbase=(long)b*KVR; const int q0=qb*QB;
  const bf16*Qw=Q+(rowbase+q0+wid*QBLK)*DM+h*D;
  const bf16*Kh=K+(kvbase+64*tile0)*DM+h*D,*Vh=V+(kvbase+64*tile0)*DM+h*D;
  const unsigned lds0=(unsigned)(uintptr_t)shm;
  float*wsf=(float*)(shm+LDS_WS)+wid*64;
  const bf16*ksrc=Kh+(long)lane*DM+wid*8;
  const bf16*vsrc=Vh+(long)(16*(wid&3)+(lane>>2))*DM+(wid>>2)*32+(lane&3)*8;
  const unsigned kdst=lds0+LDS_K+wid*1024, vdst=lds0+LDS_V+wid*1024;
  #define DMA_K(t,slot) glds16(ksrc+(long)(t)*KVBLK*DM,(unsigned)__builtin_amdgcn_readfirstlane(kdst+(slot)))
  #define DMA_V(t,slot) glds16(vsrc+(long)(t)*KVBLK*DM,(unsigned)__builtin_amdgcn_readfirstlane(vdst+(slot)))
  const int vb0=(int)(lds0+LDS_V)+((lane>>4)&1)*32+(lane&3)*8+(4*hi+((lane&15)>>2))*64;
  const char*Kbase=shm+LDS_K; bf16x8 kf[8];
  const lds_cptr shm3=(lds_cptr)shm; const lds_cptr kp0=shm3+LDS_K+hi*1024+r32*16; const lds_cptr vp0=shm3+LDS_V+((lane>>4)&1)*32+(lane&3)*8+(4*hi+((lane&15)>>2))*64;
  DMA_K(0,0);DMA_V(0,0);DMA_K(1,SLOTB);
  bf16x8 qr[4];
  #pragma unroll
  for(int d0=0;d0<4;++d0)qr[d0]=*reinterpret_cast<const bf16x8*>(&Qw[(long)r32*DM+d0*16+hi*8]);
  float l_reg=0.f;f32x16 o[2];o[0]=f32x16{};o[1]=f32x16{};
  const float qf=fq[wid*QBLK+r32];
  #define NBLD(N0,N1,t) do{ const __attribute__((address_space(3))) f32x4_t*fp_=(const __attribute__((address_space(3))) f32x4_t*)(fk+64*(t)+4*hi); \
    _Pragma("unroll") for(int g_=0;g_<4;++g_){ const f32x4_t a_=fp_[2*g_], b_=fp_[2*g_+8]; \
      _Pragma("unroll") for(int i_=0;i_<4;++i_){ N0[4*g_+i_]=qf-a_[i_]; N1[4*g_+i_]=qf-b_[i_]; } } }while(0)
  const int qrel=wid*QBLK+r32;
  #define CMASK(P0,P1,t) do{int jb_=(t)-(NT-4); if(band&&jb_>=0)cmask(P0,P1,jb_,qrel,hi);}while(0)
  #define START(P0,P1) do{ _Pragma("unroll") for(int r=0;r<16;++r)P0[r]=__builtin_amdgcn_exp2f(P0[r]); }while(0)
  #define RESC() do{}while(0)
  f32x16 pA0,pA1,pB0,pB1;
  int sl_prev=0,sl_cur=0,sl_next=SLOTB;
  #define ROT() do{sl_prev=sl_cur;sl_cur=sl_next;sl_next=(sl_next==(NSLOT-1)*SLOTB)?0:sl_next+SLOTB;}while(0)
  DMA_K(2,2*SLOTB);
  WAIT_BAR(3);
  { f32x16 nb0_,nb1_; NBLD(nb0_,nb1_,0); qkt(pA0,pA1,Kbase,qr,nb0_,nb1_,r32,hi); }asm volatile("s_nop 15\n\ts_nop 7":"+v"(pA0),"+v"(pA1));CMASK(pA0,pA1,0);
  START(pA0,pA1);
  _Pragma("unroll") for(int r=0;r<16;++r)pA1[r]=__builtin_amdgcn_exp2f(pA1[r]);
  WAIT_BAR(0);
  DMA_K(3,0);DMA_V(1,SLOTB);
  ROT();
  kload8(kf,kp0+sl_cur);
  WAIT_BAR(2);
  s16x4 vlo[8],vhi[8]; u32x4 pw0,pw1,pw2,pw3;
  #define PKW(P,B) cvtpk_s(P[B],P[B+1])
  #define PAF(k) __builtin_bit_cast(bf16x8,pw##k)
  #define VFR(i) (bf16x8){vlo[i][0],vlo[i][1],vlo[i][2],vlo[i][3],vhi[i][0],vhi[i][1],vhi[i][2],vhi[i][3]}
  #define PIN(x) asm volatile("":"+v"(x))
  #define MX3(a,b,c) __builtin_fmaxf(__builtin_fmaxf((a),(b)),(c))
  #define GAPA(MF,A0,A1,A2,A3,W0,W1,PW) do{ MF; sacc+=A0; sacc+=A1; sacc+=A2; sacc+=A3; PIN(sacc); W0; W1; PIN(PW); SBAR(); }while(0)
  #define EX(v) __builtin_amdgcn_exp2f(v)
  #define GAPB(MF,X,B) do{ MF; X[B]=EX(X[B]); X[B+1]=EX(X[B+1]); X[B+2]=EX(X[B+2]); X[B+3]=EX(X[B+3]); PIN(X); SBAR(); }while(0)
  #define VRD(i) do{ vlo[i]=vtr(vp_+(((i)>>2)*4096+((i)&3)*1024)); vhi[i]=vtr(vp_+(((i)>>2)*4096+((i)&3)*1024+512)); }while(0)
  #define KRD(G,j) do{ if(G){ kload2(kf,kp0+sl_next,j); SBAR(); } }while(0)
  #define STEP(C0,C1,P0,P1,t,GK,GV,GL) do{ SBAR(); \
    f32x16 nb0_,nb1_; NBLD(nb0_,nb1_,t); SBAR(); \
    const lds_cptr vp_=vp0+sl_prev; \
    VRD(0); SBAR(); float sacc=(P0[0]+P0[1]); \
    GAPA(C0=__builtin_amdgcn_mfma_f32_32x32x16_bf16(kf[0],qr[0],nb0_,0,0,0), P0[2],P0[3],P0[4],P0[5],     pw0[0]=PKW(P0,0), pw0[1]=PKW(P0,2), pw0); \
    VRD(4); SBAR(); GAPA(C1=__builtin_amdgcn_mfma_f32_32x32x16_bf16(kf[1],qr[0],nb1_,0,0,0), P0[6],P0[7],P0[8],P0[9],     pw0[2]=PKW(P0,4), pw0[3]=PKW(P0,6), pw0); \
    VRD(1); SBAR(); GAPA(C0=__builtin_amdgcn_mfma_f32_32x32x16_bf16(kf[2],qr[1],C0,0,0,0),   P0[10],P0[11],P0[12],P0[13], pw1[0]=PKW(P0,8), pw1[1]=PKW(P0,10), pw1); \
    VRD(5); SBAR(); GAPA(C1=__builtin_amdgcn_mfma_f32_32x32x16_bf16(kf[3],qr[1],C1,0,0,0),   P0[14],P0[15],P1[0],P1[1],   pw1[2]=PKW(P0,12),pw1[3]=PKW(P0,14), pw1); \
    VRD(2); SBAR(); GAPA(C0=__builtin_amdgcn_mfma_f32_32x32x16_bf16(kf[4],qr[2],C0,0,0,0),   P1[2],P1[3],P1[4],P1[5],     pw2[0]=PKW(P1,0), pw2[1]=PKW(P1,2), pw2); \
    VRD(6); SBAR(); GAPA(C1=__builtin_amdgcn_mfma_f32_32x32x16_bf16(kf[5],qr[2],C1,0,0,0),   P1[6],P1[7],P1[8],P1[9],     pw2[2]=PKW(P1,4), pw2[3]=PKW(P1,6), pw2); \
    VRD(3); SBAR(); GAPA(C0=__builtin_amdgcn_mfma_f32_32x32x16_bf16(kf[6],qr[3],C0,0,0,0),   P1[10],P1[11],P1[12],P1[13], pw3[0]=PKW(P1,8), pw3[1]=PKW(P1,10), pw3); \
    VRD(7); SBAR(); GAPA(C1=__builtin_amdgcn_mfma_f32_32x32x16_bf16(kf[7],qr[3],C1,0,0,0),   P1[14],P1[15],0.f,0.f,       pw3[2]=PKW(P1,12),pw3[3]=PKW(P1,14), pw3); \
    l_reg+=sacc; \
    if(GK){DMA_K((t)+3,sl_cur);} if(GV){DMA_V((t)+1,sl_next);} \
    CMASK(C0,C1,t); \
    SBAR(); \
    GAPB(o[0]=__builtin_amdgcn_mfma_f32_32x32x16_bf16(PAF(0),VFR(0),o[0],0,0,0), C0,0); \
    GAPB(o[1]=__builtin_amdgcn_mfma_f32_32x32x16_bf16(PAF(0),VFR(4),o[1],0,0,0), C0,4); \
    KRD(GL,0); GAPB(o[0]=__builtin_amdgcn_mfma_f32_32x32x16_bf16(PAF(1),VFR(1),o[0],0,0,0), C0,8); \
    KRD(GL,1); GAPB(o[1]=__builtin_amdgcn_mfma_f32_32x32x16_bf16(PAF(1),VFR(5),o[1],0,0,0), C0,12); \
    KRD(GL,2); GAPB(o[0]=__builtin_amdgcn_mfma_f32_32x32x16_bf16(PAF(2),VFR(2),o[0],0,0,0), C1,0); \
    KRD(GL,3); GAPB(o[1]=__builtin_amdgcn_mfma_f32_32x32x16_bf16(PAF(2),VFR(6),o[1],0,0,0), C1,4); \
    GAPB(o[0]=__builtin_amdgcn_mfma_f32_32x32x16_bf16(PAF(3),VFR(3),o[0],0,0,0), C1,8); \
    GAPB(o[1]=__builtin_amdgcn_mfma_f32_32x32x16_bf16(PAF(3),VFR(7),o[1],0,0,0), C1,12); \
    }while(0)
  int t=1;
  #undef CMASK
  #define CMASK(P0,P1,t) do{}while(0)
  for(;t+5<NT;t+=2){
    STEP(pB0,pB1,pA0,pA1,t,true,true,true);     WAIT_BAR(2); RESC(); ROT();
    STEP(pA0,pA1,pB0,pB1,t+1,true,true,true);   WAIT_BAR(2); RESC(); ROT();
  }
  #undef CMASK
  #define CMASK(P0,P1,t) do{int jb_=(t)-(NT-4); if(band&&jb_>=0)cmask(P0,P1,jb_,qrel,hi);}while(0)
  #define ENDW(tt) do{ if((tt)+3<NT){WAIT_BAR(2);} else if((tt)+2<NT){WAIT_BAR(1);} else {WAIT_BAR(0);} }while(0)
  for(;t+1<NT;t+=2){
    STEP(pB0,pB1,pA0,pA1,t,(t+3<NT),(t+1<NT),(t+1<NT));       ENDW(t);   RESC(); ROT();
    STEP(pA0,pA1,pB0,pB1,t+1,(t+4<NT),(t+2<NT),(t+2<NT));     ENDW(t+1); RESC(); ROT();
  }
  { float sacc=pA0[0]+pA0[1]; _Pragma("unroll") for(int r=2;r<16;++r)sacc+=pA0[r]; _Pragma("unroll") for(int r=0;r<16;++r)sacc+=pA1[r]; l_reg+=sacc;
    pw0=(u32x4){PKW(pA0,0),PKW(pA0,2),PKW(pA0,4),PKW(pA0,6)};pw1=(u32x4){PKW(pA0,8),PKW(pA0,10),PKW(pA0,12),PKW(pA0,14)};pw2=(u32x4){PKW(pA1,0),PKW(pA1,2),PKW(pA1,4),PKW(pA1,6)};pw3=(u32x4){PKW(pA1,8),PKW(pA1,10),PKW(pA1,12),PKW(pA1,14)};
    SBAR(); pv(o,vb0+sl_prev,PAF(0),PAF(1),PAF(2),PAF(3)); }
  #undef PKW
  #undef PAF
  #undef VFR
  #undef PIN
  #undef MX3
  #undef GAPA
  #undef GAPB
  #undef EX
  #undef VRD
  #undef KRD
  #undef STEP
  #undef ENDW
  if(pdump){ float*pd=pdump+(size_t)wid*33*64+lane;
    #pragma unroll
    for(int d0=0;d0<2;++d0)
      #pragma unroll
      for(int r=0;r<16;++r)pd[(d0*16+r)*64]=o[d0][r];
    pd[32*64]=l_reg; }
  else attn_finish(o,l_reg,O+(rowbase+q0+wid*QBLK)*DM+h*D,shm,wid,lane);
  asm volatile("s_waitcnt lgkmcnt(0)\n\ts_barrier":::"memory");
  #undef DMA_K
  #undef DMA_V
  #undef CMASK
  #undef START
  #undef NBLD
  #undef RESC
  #undef ROT
}
constexpr int ATTN_LDS_BYTES=LDS_BYTES;
struct AttnTensors { const bf16* Q; const bf16* K; const bf16* V; bf16* O; };
struct AttnUnit { int bh; int qb; };
struct StaticOrder {
  int vcu;
  __device__ __forceinline__ explicit StaticOrder(int grid,int block):vcu((block%8)*(grid/8)+block/8){}
  __device__ __forceinline__ bool next(int i,AttnUnit&u)const{ if(i>=4)return false; const int s=vcu&7; u.bh=vcu>>3; u.qb=(i==0)?s:(i==1)?15-s:(i==2)?16+s:31-s; return true; }
  __device__ __forceinline__ void a_ready(const AttnUnit&)const{}
  __device__ __forceinline__ void done(const AttnUnit&)const{}
};
#undef SBAR
#undef WAIT_BAR
}
#define GAS __attribute__((address_space(1)))
#define LAS __attribute__((address_space(3)))
typedef unsigned short bf16;
typedef unsigned v4u __attribute__((ext_vector_type(4)));
typedef float f32x4 __attribute__((ext_vector_type(4)));
typedef short bf16x8 __attribute__((ext_vector_type(8)));
typedef GAS unsigned gu32;
typedef GAS unsigned long long gu64;
#define RLX_AGENT __ATOMIC_RELAXED, __HIP_MEMORY_SCOPE_AGENT
#define LDS_WAIT() asm volatile("s_waitcnt lgkmcnt(0)" ::: "memory")
#define LDS_BARRIER() asm volatile("s_waitcnt lgkmcnt(0)\n\ts_barrier" ::: "memory")
#define VM_WAIT() asm volatile("s_waitcnt vmcnt(0)" ::: "memory")
__device__ __forceinline__ unsigned long long rt() { return __builtin_amdgcn_s_memrealtime(); }
__device__ __forceinline__ unsigned f2bf(float f) { unsigned u = __builtin_bit_cast(unsigned, f); return (u + 0x7fffu + ((u >> 16) & 1u)) >> 16; }
__device__ __forceinline__ unsigned pk2(float lo, float hi) { return f2bf(lo) | (f2bf(hi) << 16); }
typedef __bf16 bf16v2_t __attribute__((ext_vector_type(2)));
typedef float f32v2_t __attribute__((ext_vector_type(2)));
__device__ __forceinline__ unsigned pk2h(float lo, float hi) { const f32v2_t v = {lo, hi}; const bf16v2_t b = __builtin_convertvector(v, bf16v2_t); return __builtin_bit_cast(unsigned, b); }

#define XB_TMO      128
#define XB_XCNT(j)  (256  + 64 * (j))
#define XB_XSUB(j)  (1280 + 64 * (j))
#define XB_XGEN(j)  (2304 + 64 * (j))
#define XB_TOP      3328
#define XB_TOPGEN   3392
#define XCD_BAR_WORDS 3456
#define XB_SPIN_CAP (1u << 18)

__device__ __forceinline__ unsigned xb_ld(unsigned* p)              { return __hip_atomic_load(p, __ATOMIC_RELAXED, __HIP_MEMORY_SCOPE_AGENT); }
__device__ __forceinline__ unsigned xb_add(unsigned* p, unsigned v) { return __hip_atomic_fetch_add(p, v, __ATOMIC_RELAXED, __HIP_MEMORY_SCOPE_AGENT); }
__device__ __forceinline__ unsigned xb_xcc_id() { return (unsigned)__builtin_amdgcn_s_getreg((3 << 11) | 20) & 0xFu; }
#define XB_SPIN(cond, bar) do { unsigned _sp = 0; while (cond) { __builtin_amdgcn_s_sleep(1); \
    if ((++_sp & 255u) == 0u) { if (xb_ld(&(bar)[XB_TMO])) break; if (_sp > XB_SPIN_CAP) { atomicAdd(&(bar)[XB_TMO], 1u); break; } } } } while (0)

struct XcdBarrier {
    unsigned* bar; unsigned x;
    volatile LAS unsigned* st;
};

__device__ __forceinline__ XcdBarrier xcd_barrier_post(unsigned* bar, volatile LAS unsigned* st) {
    XcdBarrier b; b.bar = bar; b.x = xb_xcc_id(); b.st = st;
    if (threadIdx.x == 0) (void)xb_add(&bar[XB_XCNT(b.x)], 1u);
    return b;
}
__device__ __forceinline__ void xcd_barrier_complete(unsigned* bar, unsigned x, unsigned& nloc, unsigned& nx) {
    const unsigned G = gridDim.x * gridDim.y * gridDim.z;
    unsigned sum, cnt, mine, sp = 0u;
    for (;;) {
        sum = 0u; cnt = 0u; mine = 0u;
#pragma unroll
        for (unsigned j = 0; j < 16; ++j) { const unsigned c = xb_ld(&bar[XB_XCNT(j)]); sum += c; cnt += (c > 0u) ? 1u : 0u; mine = (j == x) ? c : mine; }
        if (sum == G) break;
        __builtin_amdgcn_s_sleep(1);
        if ((++sp & 255u) == 0u) { if (xb_ld(&bar[XB_TMO])) break; if (sp > XB_SPIN_CAP) { atomicAdd(&bar[XB_TMO], 1u); break; } }
    }
    nloc = mine > 0u ? mine : 1u; nx = cnt > 0u ? cnt : 1u;
}

__device__ __forceinline__ void xcd_barrier(const XcdBarrier& b) {
    asm volatile("s_waitcnt vmcnt(0)" ::: "memory");
    __syncthreads();
    if (threadIdx.x == 0) {
        unsigned* bar = b.bar;
        __builtin_amdgcn_s_waitcnt(0);
        unsigned nloc = b.st[0], nx = b.st[1];
        if (nloc == 0u) { xcd_barrier_complete(bar, b.x, nloc, nx); b.st[0] = nloc; b.st[1] = nx; }
        const unsigned old = xb_add(&bar[XB_XSUB(b.x)], 1u);
        const unsigned gen = old / nloc;
        if (old + 1u == (gen + 1u) * nloc) {
            __builtin_amdgcn_fence(__ATOMIC_RELEASE, "agent");
            asm volatile("s_waitcnt vmcnt(0)" ::: "memory");
            const unsigned og = xb_add(&bar[XB_TOP], 1u);
            const unsigned tg = og / nx;
            if (og + 1u == (tg + 1u) * nx) xb_add(&bar[XB_TOPGEN], 1u);
            else XB_SPIN(xb_ld(&bar[XB_TOPGEN]) == tg, bar);
            __builtin_amdgcn_fence(__ATOMIC_ACQUIRE, "agent");
            xb_add(&bar[XB_XGEN(b.x)], 1u);
            asm volatile("s_waitcnt vmcnt(0)" ::: "memory");
        } else {
            XB_SPIN(xb_ld(&bar[XB_XGEN(b.x)]) == gen, bar);
            __builtin_amdgcn_fence(__ATOMIC_ACQUIRE, "agent");
            asm volatile("s_waitcnt vmcnt(0)" ::: "memory");
        }
    }
    __syncthreads();
}

constexpr int DM = 1024, SEQ = 8192, NBATCH = 2, TR = NBATCH * SEQ, NMETA = 16, TALL = TR + NMETA, TPAD = TR + 256, LPOS = SEQ + NMETA, KVROWS = 8256;
constexpr int NWAVES = 8;
constexpr int NPHASE = 14;
#ifndef MK_N_LAUNCHES
#define MK_N_LAUNCHES 1
#endif
constexpr int N_LAUNCHES = MK_N_LAUNCHES;

constexpr size_t MiB = 1u << 20;
constexpr size_t WS_CTL = 0, CTL_ZERO_BYTES = 1 * MiB;
constexpr size_t WS_WIN = 2 * MiB, WS_WOUT = 8 * MiB, WS_WKV = 10 * MiB, WS_WQ = 14 * MiB, WS_WO = 16 * MiB;
constexpr size_t WS_GATES = 18 * MiB;
constexpr size_t WS_RS = 19 * MiB;
constexpr size_t WS_TOKP = 19 * MiB + 128 * 1024;
constexpr size_t WS_FM = 20 * MiB;
constexpr size_t WS_FA = 20 * MiB + 512 * 1024;
constexpr size_t WS_LOGF = 22 * MiB;
constexpr size_t WS_LIST = 23 * MiB + 512 * 1024;
constexpr size_t WS_XN = 26 * MiB;
constexpr size_t WS_H1 = 59 * MiB;
constexpr size_t WS_PROJ = 59 * MiB;
constexpr size_t WS_XQ = 59 * MiB, WS_K = 92 * MiB, WS_V = 125 * MiB, WS_Q = 158 * MiB, WS_AO = WS_Q;
constexpr size_t WS_W1T = 192 * MiB, WS_W2T = 224 * MiB;
constexpr size_t WS_ACT = 92 * MiB;
constexpr size_t WS_KVL = 174 * MiB + 512 * 1024;
constexpr size_t WS_CIN = 157 * MiB;
constexpr int LISTCAP = 16400;
constexpr int CW_BAR = 4096;
constexpr int CW_CNT = 16384;
constexpr int CW_RDY = 20480;

constexpr int RING_OFF = 0, RING_BYTES = 139264;
constexpr int LDSCTL_OFF = RING_BYTES, MISC_OFF = LDSCTL_OFF + 320;
constexpr int LDS_BYTES = 159744;

typedef unsigned short bf16;
typedef unsigned v4u __attribute__((ext_vector_type(4)));
typedef unsigned v2u __attribute__((ext_vector_type(2)));
typedef float f32x4 __attribute__((ext_vector_type(4)));
typedef short rp_bf16x8 __attribute__((ext_vector_type(8)));

__device__ __forceinline__ float wave_sum(float v) {
#pragma unroll
    for (int o = 1; o < 64; o <<= 1) v += __shfl_xor(v, o);
    return v;
}
__device__ __forceinline__ float wave_max(float v) {
#pragma unroll
    for (int o = 1; o < 64; o <<= 1) v = fmaxf(v, __shfl_xor(v, o));
    return v;
}
__device__ __forceinline__ float bflo(unsigned u) { return __uint_as_float(u << 16); }
__device__ __forceinline__ float bfhi(unsigned u) { return __uint_as_float(u & 0xffff0000u); }
__device__ __forceinline__ float log_sigmoidf(float x) { return fminf(x, 0.f) - log1pf(expf(-fabsf(x))); }
__device__ __forceinline__ float dot4(f32x4 a, f32x4 b) { return (a.x * b.x + a.y * b.y) + (a.z * b.z + a.w * b.w); }
__device__ __forceinline__ float dot8bf(v4u a, v4u b) {
    return (bflo(a.x) * bflo(b.x) + bfhi(a.x) * bfhi(b.x)) + (bflo(a.y) * bflo(b.y) + bfhi(a.y) * bfhi(b.y)) +
           (bflo(a.z) * bflo(b.z) + bfhi(a.z) * bfhi(b.z)) + (bflo(a.w) * bflo(b.w) + bfhi(a.w) * bfhi(b.w));
}
__device__ __forceinline__ unsigned long long pack4bf(f32x4 v) { return (unsigned long long)pk2(v.x, v.y) | ((unsigned long long)pk2(v.z, v.w) << 32); }


template <int N> __device__ __forceinline__ float reduce_scatter(float (&s)[N], int lane) {
    int n = N, k = 0;
#pragma unroll
    for (; n > 1; n >>= 1, ++k) {
        const bool up = (lane >> k) & 1;
#pragma unroll
        for (int i = 0; i < n / 2; ++i) { const float a = s[i], b = s[i + n / 2]; const float keep = up ? b : a, send = up ? a : b; s[i] = keep + __shfl_xor(send, 1 << k); }
    }
    float t = s[0];
#pragma unroll
    for (int o = N; o < 64; o <<= 1) t += __shfl_xor(t, o);
    return t;
}
template <int N> __host__ __device__ constexpr int rsc_lane(int c) {
    int l = 0, bits = 0; for (int n = N; n > 1; n >>= 1) ++bits;
    for (int k = 0; k < bits; ++k) l |= ((c >> (bits - 1 - k)) & 1) << k;
    return l;
}
template <int NC, int NP> __device__ __forceinline__ float row_dots_rs(const f32x4 (&v)[4], const LAS float* Wl, int lane) {
    float s[NP];
#pragma unroll
    for (int c = 0; c < NP; ++c) { s[c] = 0.f;
        if (c < NC) {
#pragma unroll
            for (int j = 0; j < 4; ++j) s[c] += dot4(v[j], ((const LAS f32x4*)(Wl + c * 1024))[lane + 64 * j]); } }
    return reduce_scatter<NP>(s, lane);
}

template <int NC> __device__ __forceinline__ float row_dots(const f32x4 (&v)[4], const LAS float* Wl, int lane) {
    float val = 0.f;
#pragma unroll 1
    for (int c0 = 0; c0 < NC; c0 += 4) {
        float s[4];
#pragma unroll
        for (int g = 0; g < 4; ++g) { s[g] = 0.f;
#pragma unroll
            for (int j = 0; j < 4; ++j) s[g] += dot4(v[j], ((const LAS f32x4*)(Wl + (c0 + g) * 1024))[lane + 64 * j]); }
#pragma unroll
        for (int o = 1; o < 64; o <<= 1) {
#pragma unroll
            for (int g = 0; g < 4; ++g) s[g] += __shfl_xor(s[g], o); }
#pragma unroll
        for (int g = 0; g < 4; ++g) val = (lane == c0 + g) ? s[g] : val;
    }
    return val;
}
__device__ __forceinline__ void transpose_item(const float* W, int K, int N, int ldw, bf16* WT, LAS float* scr, int item, int lane, int ldt = 0, const float* gain = nullptr) {
    if (ldt == 0) ldt = K;
    const int nblk = N / 32, kb = item / nblk, nb = item % nblk, k0 = 64 * kb, n0 = 32 * nb;
    f32x4 t4[8];
#pragma unroll
    for (int i = 0; i < 8; ++i) { const int idx = i * 64 + lane; t4[i] = *(const f32x4*)(W + (size_t)(k0 + (idx >> 3)) * ldw + n0 + (idx & 7) * 4); }
    if (gain) {
#pragma unroll
        for (int i = 0; i < 8; ++i) t4[i] = t4[i] * gain[k0 + ((i * 64 + lane) >> 3)]; }
#pragma unroll
    for (int i = 0; i < 8; ++i) { const int idx = i * 64 + lane; LAS float* d = scr + (idx >> 3) * 33 + (idx & 7) * 4; d[0] = t4[i][0]; d[1] = t4[i][1]; d[2] = t4[i][2]; d[3] = t4[i][3]; }
    LDS_WAIT(); asm volatile("" ::: "memory");
    const int c = lane & 7;
#pragma unroll
    for (int j = 0; j < 4; ++j) { const int n = (lane >> 3) + 8 * j; const LAS float* s = scr + (8 * c) * 33 + n;
        v4u o; o.x = pk2(s[0 * 33], s[1 * 33]); o.y = pk2(s[2 * 33], s[3 * 33]); o.z = pk2(s[4 * 33], s[5 * 33]); o.w = pk2(s[6 * 33], s[7 * 33]);
        *(GAS v4u*)(WT + (size_t)(n0 + n) * ldt + k0 + 8 * c) = o; }
    LDS_WAIT(); asm volatile("" ::: "memory");
}

struct TrPtrs { const float *w_in, *w_out, *kv_w, *w_q, *w_o, *mw_gate, *mw_up, *mw_down, *gkv, *gq1, *gffn; bf16 *Win_t, *Wout_t, *Wkv_t, *Wq_t, *Wo_t, *W1t, *W2t; };
struct TrItem { const float* src; bf16* dst; const float* gain; int ldw, ldt; };
template <int SET> __device__ __forceinline__ TrItem tr_decode(const TrPtrs& P, int idx) {
    constexpr int I_IN = 16 * 96, I_SQ = 16 * 32, I_KV = 16 * 64, NDENSE = I_IN + 3 * I_SQ + I_KV, NW1 = 2 * 16 * 2 * 128;
    int it;
    if (SET == 0) it = idx < 4096 ? idx : (idx < 8192 ? NDENSE + (idx - 4096) : NDENSE + NW1 + (idx - 8192));
    else it = idx < 4096 ? NDENSE + 4096 + idx : NDENSE + NW1 + idx;
    TrItem d; const float* W; bf16* WT; int N, ldw, ldt = 1024, item; const float* gain = nullptr;
    if (SET == 0 && it < NDENSE) { int r = it;
        if (r < I_IN) { W = P.w_in; N = 3072; ldw = 3080; WT = P.Win_t; item = r; }
        else if ((r -= I_IN) < I_SQ) { W = P.w_out; N = 1024; ldw = 1024; WT = P.Wout_t; item = r; }
        else if ((r -= I_SQ) < I_KV) { W = P.kv_w; N = 2048; ldw = 2064; WT = P.Wkv_t; item = r; gain = P.gkv; }
        else if ((r -= I_KV) < I_SQ) { W = P.w_q; N = 1024; ldw = 1024; WT = P.Wq_t; item = r; gain = P.gq1; }
        else { r -= I_SQ; W = P.w_o; N = 1024; ldw = 1024; WT = P.Wo_t; item = r; } }
    else if (it < NDENSE + NW1) { const int j = it - NDENSE, mat = j >> 7, which = mat & 1, le = mat >> 1; item = ((j & 15) << 3) | ((j & 127) >> 4); const int fblk = (item & 7) >> 2;
        W = (which ? P.mw_up : P.mw_gate) + (size_t)le * 1024 * 256; N = 256; ldw = 256; WT = P.W1t + ((size_t)(le * 2 + fblk) * 256 + which * 128 - fblk * 128) * 1024; gain = P.gffn + (le >> 4) * DM; }
    else { const int j = it - NDENSE - NW1, lb = j >> 7, L = lb >> 5, gb = lb & 31, grp = gb >> 3, bi = gb & 7; item = (j & 3) * 32 + ((j & 127) >> 2);
        const int ex = bi < 4 ? bi : (bi == 4 ? 0 : (bi == 5 ? 2 : (bi == 6 ? 1 : 3)));
        W = P.mw_down + (size_t)(L * 16 + grp * 4 + ex) * 256 * 1024; N = 1024; ldw = 1024; WT = P.W2t + (size_t)L * 1024 * 8192 + gb * 256; ldt = 8192; }
    const int nblk = N / 32, kb = item / nblk, nb = item - kb * nblk, k0 = 64 * kb, n0 = 32 * nb;
    d.src = W + (size_t)k0 * ldw + n0; d.dst = WT + (size_t)n0 * ldt + k0; d.gain = gain ? gain + k0 : nullptr; d.ldw = ldw; d.ldt = ldt; return d;
}
template <int SET> __device__ __forceinline__ void ph_transposes(const TrPtrs& P, LAS float* scr, int w, int NW, int lane) {
    constexpr int NITEMS = SET == 0 ? 12288 : 8192;
    f32x4 t4[8]; float gn[8];
    int it = w;
    TrItem cur = tr_decode<SET>(P, it < NITEMS ? it : 0);
    if (it < NITEMS) {
#pragma unroll
        for (int i = 0; i < 8; ++i) { const int idx = i * 64 + lane; t4[i] = *(const f32x4*)(cur.src + (size_t)(idx >> 3) * cur.ldw + (idx & 7) * 4); gn[i] = cur.gain ? cur.gain[idx >> 3] : 1.f; } }
#pragma unroll 1
    for (; it < NITEMS; it += NW) {
        const bool has = it + NW < NITEMS;
        const TrItem nxt = tr_decode<SET>(P, has ? it + NW : it);
        f32x4 t4n[8]; float gnn[8];
        if (has) {
#pragma unroll
            for (int i = 0; i < 8; ++i) { const int idx = i * 64 + lane; t4n[i] = *(const f32x4*)(nxt.src + (size_t)(idx >> 3) * nxt.ldw + (idx & 7) * 4); gnn[i] = nxt.gain ? nxt.gain[idx >> 3] : 1.f; } }
        else {
#pragma unroll
            for (int i = 0; i < 8; ++i) { t4n[i] = t4[i]; gnn[i] = gn[i]; } }
#pragma unroll
        for (int i = 0; i < 8; ++i) { const int idx = i * 64 + lane; LAS float* dd = scr + (idx >> 3) * 33 + (idx & 7) * 4; const f32x4 v = t4[i] * gn[i]; dd[0] = v[0]; dd[1] = v[1]; dd[2] = v[2]; dd[3] = v[3]; }
        LDS_WAIT(); asm volatile("" ::: "memory");
        const int c = lane & 7;
#pragma unroll
        for (int j = 0; j < 4; ++j) { const int n = (lane >> 3) + 8 * j; const LAS float* s = scr + (8 * c) * 33 + n;
            v4u o; o.x = pk2h(s[0 * 33], s[1 * 33]); o.y = pk2h(s[2 * 33], s[3 * 33]); o.z = pk2h(s[4 * 33], s[5 * 33]); o.w = pk2h(s[6 * 33], s[7 * 33]);
            *(GAS v4u*)(cur.dst + (size_t)n * cur.ldt + 8 * c) = o; }
        LDS_WAIT(); asm volatile("" ::: "memory");
        cur = nxt;
#pragma unroll
        for (int i = 0; i < 8; ++i) { t4[i] = t4n[i]; gn[i] = gnn[i]; }
    }
}

__device__ __forceinline__ void ph_prologue(const float* x, const float* meta, const float* gmix0, const float* w_in, const float* b_gate, const TrPtrs& TP, bf16* XN, float* gates,
                                            LAS unsigned char* lds, int gw, int NGW, int tid, int lane, int wave) {
    LAS float* Wl = (LAS float*)lds;
    LAS float* scr = (LAS float*)(lds + 32768 + wave * 8704);
    const bool rows_first = ((gw >> 3) & 1) != 0;
    if (!rows_first) ph_transposes<0>(TP, scr, gw, NGW, lane);
    __syncthreads();
    {
        LAS bf16* Bl1 = (LAS bf16*)lds;
        LAS bf16* Bl2 = (LAS bf16*)(lds + 16384);
        LAS float* ssq = (LAS float*)(lds + 32768);
        LAS f32x4* part = (LAS f32x4*)(lds + 33792);
        for (int d = tid; d < 1024; d += 512) { const float gd = gmix0[d];
#pragma unroll
            for (int q = 0; q < 2; ++q) { const f32x4 w4 = *(const f32x4*)(w_in + (size_t)d * 3080 + 3072 + 4 * q);
#pragma unroll
                for (int e = 0; e < 4; ++e) { const float w = w4[e] * gd; const unsigned hi1 = f2bf(w); Bl1[(4 * q + e) * 1024 + d] = (bf16)hi1; Bl2[(4 * q + e) * 1024 + d] = (bf16)f2bf(w - __uint_as_float(hi1 << 16)); } } }
        __syncthreads();
        const int r16 = lane & 15, g4 = lane >> 4, kb = wave * 128 + 8 * g4, vcu_ = gw >> 3;
        const int ntile = vcu_ == 0 ? 5 : 4;
        f32x4 gg[4][2];
#pragma unroll
        for (int ks = 0; ks < 4; ++ks) { gg[ks][0] = *(const f32x4*)(gmix0 + kb + 32 * ks); gg[ks][1] = *(const f32x4*)(gmix0 + kb + 32 * ks + 4); }
        const float bgate = b_gate[(tid >> 2) & 7];
        f32x4 hv[4][2];
        { const float* src = x + (size_t)(vcu_ * 64 + r16) * DM + kb;
#pragma unroll
          for (int ks = 0; ks < 4; ++ks) { hv[ks][0] = *(const f32x4*)(src + 32 * ks); hv[ks][1] = *(const f32x4*)(src + 32 * ks + 4); } }
#pragma unroll 1
        for (int it = 0; it < ntile; ++it) {
            const int R0 = it < 4 ? vcu_ * 64 + it * 16 : TR;
            const int row = R0 + r16;
            f32x4 hn[4][2];
            { const int rown = (it + 1 < 4 ? vcu_ * 64 + (it + 1) * 16 : TR) + r16; const float* srcn = (rown < TR ? x + (size_t)rown * DM : meta + (size_t)(rown - TR) * DM) + kb;
              if (it + 1 < ntile) {
#pragma unroll
                  for (int ks = 0; ks < 4; ++ks) { hn[ks][0] = *(const f32x4*)(srcn + 32 * ks); hn[ks][1] = *(const f32x4*)(srcn + 32 * ks + 4); } }
              else {
#pragma unroll
                  for (int ks = 0; ks < 4; ++ks) { hn[ks][0] = hv[ks][0]; hn[ks][1] = hv[ks][1]; } } }
            float ss = 0.f;
#pragma unroll
            for (int ks = 0; ks < 4; ++ks) ss += dot4(hv[ks][0], hv[ks][0]) + dot4(hv[ks][1], hv[ks][1]);
            ss += __shfl_xor(ss, 16); ss += __shfl_xor(ss, 32);
            if (g4 == 0) ssq[(it & 1) * 128 + wave * 16 + r16] = ss;
            f32x4 acc = {0.f, 0.f, 0.f, 0.f};
            const int colc = r16 < 8 ? r16 : 7;
#pragma unroll
            for (int ks = 0; ks < 4; ++ks) {
                unsigned p1[4], p2[4];
#pragma unroll
                for (int q = 0; q < 4; ++q) { const float x0 = hv[ks][q >> 1][(q & 1) * 2], x1 = hv[ks][q >> 1][(q & 1) * 2 + 1];
                    p1[q] = pk2h(x0, x1);
                    p2[q] = pk2h(x0 - __uint_as_float(p1[q] << 16), x1 - __uint_as_float(p1[q] & 0xffff0000u)); }
                const rp_bf16x8 A1 = __builtin_bit_cast(rp_bf16x8, (v4u){p1[0], p1[1], p1[2], p1[3]}), A2 = __builtin_bit_cast(rp_bf16x8, (v4u){p2[0], p2[1], p2[2], p2[3]});
                const rp_bf16x8 B1 = *(const LAS rp_bf16x8*)(Bl1 + colc * 1024 + kb + 32 * ks), B2 = *(const LAS rp_bf16x8*)(Bl2 + colc * 1024 + kb + 32 * ks);
                acc = __builtin_amdgcn_mfma_f32_16x16x32_bf16(A1, B1, acc, 0, 0, 0);
                acc = __builtin_amdgcn_mfma_f32_16x16x32_bf16(A1, B2, acc, 0, 0, 0);
                acc = __builtin_amdgcn_mfma_f32_16x16x32_bf16(A2, B1, acc, 0, 0, 0);
            }
            part[(it & 1) * 512 + wave * 64 + lane] = acc;
            LDS_BARRIER();
            float rstd_own;
            { float q = 0.f;
#pragma unroll
              for (int w = 0; w < 8; ++w) q += ssq[(it & 1) * 128 + w * 16 + r16];
              rstd_own = rsqrtf(q * (1.f / DM) + 1e-6f); }
            if (tid < 256) { const int ln = tid >> 2, i = tid & 3, rr = 4 * (ln >> 4) + i, cc = ln & 15;
                if (cc < 8) { float sacc = 0.f, q = 0.f;
#pragma unroll
                    for (int w = 0; w < 8; ++w) { sacc += ((const LAS float*)(part + (it & 1) * 512))[(w * 64 + ln) * 4 + i]; q += ssq[(it & 1) * 128 + w * 16 + rr]; }
                    float val = sacc * rsqrtf(q * (1.f / DM) + 1e-6f) + bgate; val = 15.f * tanhf(val * (1.f / 15.f)); if (cc >= 4) val = log_sigmoidf(val);
                    gates[(size_t)(R0 + rr) * 8 + cc] = val; } }
#pragma unroll
            for (int ks = 0; ks < 4; ++ks) { const f32x4 y0 = hv[ks][0] * rstd_own * gg[ks][0], y1 = hv[ks][1] * rstd_own * gg[ks][1];
                v4u o; o.x = pk2h(y0[0], y0[1]); o.y = pk2h(y0[2], y0[3]); o.z = pk2h(y1[0], y1[1]); o.w = pk2h(y1[2], y1[3]);
                *(v4u*)(XN + (size_t)row * DM + kb + 32 * ks) = o; }
#pragma unroll
            for (int ks = 0; ks < 4; ++ks) { hv[ks][0] = hn[ks][0]; hv[ks][1] = hn[ks][1]; }
        }
    }
    if (rows_first) { __syncthreads(); ph_transposes<0>(TP, scr, gw, NGW, lane); }
}

__device__ __forceinline__ void scan_seq(const float* src, int ld, int off, int nh, int nseq, float* Fout, int gw, int NGW, int lane) {
    for (int sq = gw; sq < nseq; sq += NGW) {
        const int b = sq / nh, h = sq % nh, p0 = lane * 129;
        float s = 0.f;
        for (int i = 0; i < 129; ++i) { const int p = p0 + i; if (p < LPOS) { const int row = p < NMETA ? TR + p : b * SEQ + p - NMETA; s += src[(size_t)row * ld + off + h]; } }
        float incl = s;
#pragma unroll
        for (int o = 1; o < 64; o <<= 1) { const float t = __shfl_up(incl, o); if (lane >= o) incl += t; }
        float run = incl - s;
        for (int i = 0; i < 129; ++i) { const int p = p0 + i; if (p < LPOS) { const int row = p < NMETA ? TR + p : b * SEQ + p - NMETA; run += src[(size_t)row * ld + off + h]; Fout[(size_t)sq * LPOS + p] = run; } }
    }
}

__device__ __forceinline__ void ph_mlstm_naive(const bf16* PROJ, const float* gates, const float* Fm, const float* g_out, bf16* HM, int gw, int NGW, int lane) {
    for (int it = gw; it < 4 * TALL; it += NGW) {
        const int r = it >> 2, h = it & 3;
        const int b = r < TR ? r / SEQ : 0, p = r < TR ? NMETA + (r % SEQ) : r - TR;
        const float* Fb = Fm + (size_t)(b * 4 + h) * LPOS; const float Fp = Fb[p];
        v4u q[16];
#pragma unroll
        for (int i = 0; i < 16; ++i) q[i] = ((const v4u*)(PROJ + (size_t)r * 3072 + h * 128))[i];
        float acc0 = 0.f, acc1 = 0.f, acc2 = 0.f, acc3 = 0.f, den = 0.f;
        const int nchunk = p / 64 + 1;
        for (int c = 0; c < nchunk; ++c) {
            const int s = c * 64 + lane; const bool valid = s <= p; const int sc = valid ? s : p;
            const int krow = sc < NMETA ? TR + sc : b * SEQ + sc - NMETA;
            const v4u* kp = (const v4u*)(PROJ + (size_t)krow * 3072 + 512 + h * 128);
            float d = 0.f;
#pragma unroll
            for (int i = 0; i < 16; ++i) d += dot8bf(q[i], kp[i]);
            const float w = valid ? __expf(Fp - Fb[sc] + gates[(size_t)krow * 8 + h]) : 0.f;
            const float cv = w * d; den += cv;
            const int jmax = (p - c * 64) < 63 ? (p - c * 64) : 63;
            for (int j = 0; j <= jmax; ++j) {
                const float cj = __shfl(cv, j); const int sj = c * 64 + j;
                const int vrow = sj < NMETA ? TR + sj : b * SEQ + sj - NMETA;
                const v2u vv = *(const v2u*)(PROJ + (size_t)vrow * 3072 + 1024 + h * 256 + lane * 4);
                acc0 += cj * bflo(vv.x); acc1 += cj * bfhi(vv.x); acc2 += cj * bflo(vv.y); acc3 += cj * bfhi(vv.y);
            }
        }
        den = wave_sum(den);
        const float dn = 1.f / fmaxf(fabsf(den), 1.f);
        acc0 *= dn; acc1 *= dn; acc2 *= dn; acc3 *= dn;
        const float ss = wave_sum((acc0 * acc0 + acc1 * acc1) + (acc2 * acc2 + acc3 * acc3));
        const float rstd = rsqrtf(ss * (1.f / 256.f) + 1e-6f);
        const v2u ov = *(const v2u*)(PROJ + (size_t)r * 3072 + 2048 + h * 256 + lane * 4);
        const f32x4 gv = *(const f32x4*)(g_out + h * 256 + lane * 4);
        f32x4 o;
        o.x = acc0 * rstd * gv.x / (1.f + __expf(-bflo(ov.x))); o.y = acc1 * rstd * gv.y / (1.f + __expf(-bfhi(ov.x)));
        o.z = acc2 * rstd * gv.z / (1.f + __expf(-bflo(ov.y))); o.w = acc3 * rstd * gv.w / (1.f + __expf(-bfhi(ov.y)));
        *(unsigned long long*)(HM + (size_t)r * DM + h * 256 + lane * 4) = pack4bf(o);
    }
}

__device__ __forceinline__ void ph_norm_router(const bf16* H, int nrows, const float* g, const float* w_group, const float* b_group, const float* w_router, const float* b_router,
                                               float* LP, gu32* cnt, int* list, LAS unsigned char* lds, int vcu, int tid, int lane, int wave) {
    LAS bf16* Bl1 = (LAS bf16*)lds;
    LAS bf16* Bl2 = (LAS bf16*)(lds + 40960);
    LAS float* ssq = (LAS float*)(lds + 81920);
    LAS f32x4* part = (LAS f32x4*)(lds + 82944);
    LAS float* lgt = (LAS float*)(lds + 115712);
    LAS float* rsl = (LAS float*)(lds + 125952);
    LAS int* hist = (LAS int*)(lds + 126336);
    LAS int* gbase = hist + 32;
    LAS int* rinfo = hist + 64;
    LAS int* bkl = hist + 144;
    LAS float* bia = (LAS float*)(hist + 224);
    LAS f32x4* rpi = (LAS f32x4*)(hist + 256);
    for (int d = tid; d < 1024; d += 512) {
        const float gd = g[d]; const f32x4 wg4 = ((const f32x4*)w_group)[d];
        float w[20];
#pragma unroll
        for (int e = 0; e < 4; ++e) w[e] = wg4[e] * gd;
#pragma unroll
        for (int q = 0; q < 4; ++q) { const f32x4 wr4 = ((const f32x4*)w_router)[4 * d + q];
#pragma unroll
            for (int e = 0; e < 4; ++e) w[4 + 4 * q + e] = wr4[e] * gd; }
#pragma unroll
        for (int c = 0; c < 20; ++c) { const unsigned hi1 = f2bf(w[c]); const float res = w[c] - __uint_as_float(hi1 << 16); Bl1[c * 1024 + d] = (bf16)hi1; Bl2[c * 1024 + d] = (bf16)f2bf(res); }
    }
    if (tid < 24) hist[tid] = 0;
    if (tid < 80) rinfo[tid] = -1;
    if (tid >= 128 && tid < 148) bia[tid - 128] = tid < 132 ? b_group[tid - 128] : b_router[tid - 132];
    __syncthreads();
    const int r16 = lane & 15, g4 = lane >> 4, kb = wave * 128 + 8 * g4;
    const int ntile = (vcu == 0 && nrows > TR) ? 5 : 4;
    v4u hv[4];
    { const bf16* src = H + (size_t)(vcu * 64 + r16) * DM + kb;
#pragma unroll
      for (int ks = 0; ks < 4; ++ks) hv[ks] = *(const v4u*)(src + 32 * ks); }
#pragma unroll 1
    for (int it = 0; it < ntile; ++it) {
        const int R0 = it < 4 ? vcu * 64 + it * 16 : TR;
        v4u hn[4];
        { const bf16* srcn = H + (size_t)((it + 1 < 4 ? vcu * 64 + (it + 1) * 16 : TR) + r16) * DM + kb;
          if (it + 1 < ntile) {
#pragma unroll
              for (int ks = 0; ks < 4; ++ks) hn[ks] = *(const v4u*)(srcn + 32 * ks); }
          else {
#pragma unroll
              for (int ks = 0; ks < 4; ++ks) hn[ks] = hv[ks]; } }
        float ss = 0.f;
#pragma unroll
        for (int ks = 0; ks < 4; ++ks) ss += dot8bf(hv[ks], hv[ks]);
        ss += __shfl_xor(ss, 16); ss += __shfl_xor(ss, 32);
        if (g4 == 0) ssq[(it & 1) * 128 + wave * 16 + r16] = ss;
        f32x4 acc[2] = {{0.f, 0.f, 0.f, 0.f}, {0.f, 0.f, 0.f, 0.f}};
#pragma unroll
        for (int ks = 0; ks < 4; ++ks) {
            const rp_bf16x8 A1 = __builtin_bit_cast(rp_bf16x8, hv[ks]);
#pragma unroll
            for (int t = 0; t < 2; ++t) { int col = 16 * t + r16; col = col < 20 ? col : 19;
                const rp_bf16x8 B1 = *(const LAS rp_bf16x8*)(Bl1 + col * 1024 + kb + 32 * ks), B2 = *(const LAS rp_bf16x8*)(Bl2 + col * 1024 + kb + 32 * ks);
                acc[t] = __builtin_amdgcn_mfma_f32_16x16x32_bf16(A1, B1, acc[t], 0, 0, 0);
                acc[t] = __builtin_amdgcn_mfma_f32_16x16x32_bf16(A1, B2, acc[t], 0, 0, 0); }
        }
        part[(it & 1) * 1024 + (wave * 2 + 0) * 64 + lane] = acc[0]; part[(it & 1) * 1024 + (wave * 2 + 1) * 64 + lane] = acc[1];
        LDS_BARRIER();
        { const int t = tid >> 8, ln = (tid >> 2) & 63, i = tid & 3, rr = 4 * (ln >> 4) + i, cc = 16 * t + (ln & 15);
          float sacc = 0.f, q = 0.f;
#pragma unroll
          for (int w = 0; w < 8; ++w) { sacc += ((const LAS float*)(part + (it & 1) * 1024))[((w * 2 + t) * 64 + ln) * 4 + i]; q += ssq[(it & 1) * 128 + w * 16 + rr]; }
          const float rstd = rsqrtf(q * (1.f / DM) + 1e-6f);
          lgt[(it * 16 + rr) * 32 + cc] = sacc * rstd;
          if (cc == 0) rsl[it * 16 + rr] = rstd; }
#pragma unroll
        for (int ks = 0; ks < 4; ++ks) hv[ks] = hn[ks];
    }
    LDS_BARRIER();
    {
        if (tid < 16 * ntile) {
            const int it = tid >> 4; const int R0 = it < 4 ? vcu * 64 + it * 16 : TR;
            const int r = R0 + (tid & 15); const LAS float* lg = lgt + tid * 32;
            float gl[4];
#pragma unroll
            for (int j = 0; j < 4; ++j) gl[j] = lg[j] + bia[j];
            int tg = 0; float gm = gl[0];
#pragma unroll
            for (int j = 1; j < 4; ++j) if (gl[j] > gm) { gm = gl[j]; tg = j; }
            float gs = 0.f;
#pragma unroll
            for (int j = 0; j < 4; ++j) gs += __expf(gl[j] - gm);
            const float pg = 1.f / gs;
            float el[4];
#pragma unroll
            for (int j = 0; j < 4; ++j) el[j] = lg[4 + 4 * tg + j] + bia[4 + 4 * tg + j];
            int i1 = 0; float v1 = el[0];
#pragma unroll
            for (int j = 1; j < 4; ++j) if (el[j] > v1) { v1 = el[j]; i1 = j; }
            int i2 = -1; float v2 = -3.0e38f;
#pragma unroll
            for (int j = 0; j < 4; ++j) if (j != i1 && el[j] > v2) { v2 = el[j]; i2 = j; }
            const float e21 = __expf(v2 - v1), p1 = pg / (1.f + e21), p2 = pg * e21 / (1.f + e21);
            const int lo = i1 < i2 ? i1 : i2, hi = i1 < i2 ? i2 : i1;
            const int pi = lo == 0 ? hi - 1 : (lo == 1 ? hi + 1 : 5);
            const int bkt = tg * 6 + pi;
            __hip_atomic_fetch_add(hist + bkt, 1, __ATOMIC_RELAXED, __HIP_MEMORY_SCOPE_WORKGROUP);
            bkl[tid] = bkt; rinfo[tid] = r << 16;
            const float rsr = rsl[tid]; rpi[tid] = (f32x4){(i1 < i2 ? p1 : p2) * rsr, (i1 < i2 ? p2 : p1) * rsr, rsr, 0.f};
        }
        LDS_BARRIER();
        if (tid < 16 * ntile) { const int bkt = bkl[tid]; int tk = 0;
            for (int j = 0; j < tid; ++j) tk += (bkl[j] == bkt) ? 1 : 0;
            rinfo[tid] |= (bkt << 8) | tk; }
    }
    __syncthreads();
    if (tid < 24) { const int n = hist[tid]; gbase[tid] = n ? (int)__hip_atomic_fetch_add(cnt + 32 * tid, (unsigned)n, __ATOMIC_RELAXED, __HIP_MEMORY_SCOPE_AGENT) : 0; }
    __syncthreads();
    if (tid < 80) { const int ri = rinfo[tid]; if (ri >= 0) { const int bkt = (ri >> 8) & 255, pos = bkt * LISTCAP + gbase[bkt] + (ri & 255); list[pos] = ri >> 16; ((f32x4*)LP)[pos] = rpi[tid]; } }
}

__device__ __forceinline__ void ph_moe_naive(const bf16* XN, const float* tokp, const gu32* cnt, const int* list, const float* Wg, const float* Wu, const float* Wd,
                                             float* h0, float* h1, LAS unsigned char* lds, int bid, int G, int tid) {
    LAS float* xs = (LAS float*)lds;
    LAS float* hu = (LAS float*)(lds + 65536);
    LAS float* act = (LAS float*)(lds + 65536 + 16384);
    LAS int* tks = (LAS int*)(lds + 65536 + 32768);
    int ntl[16]; int total = 0;
#pragma unroll
    for (int e = 0; e < 16; ++e) { const int c = (int)__hip_atomic_load(cnt + e, __ATOMIC_RELAXED, __HIP_MEMORY_SCOPE_AGENT); ntl[e] = (c + 15) >> 4; total += ntl[e]; }
    for (int g = bid; g < total; g += G) {
        int e = 0, ti = g;
#pragma unroll
        for (int k = 0; k < 16; ++k) { if (e == k && ti >= ntl[k]) { ti -= ntl[k]; e = k + 1; } }
        const int ce = (int)__hip_atomic_load(cnt + e, __ATOMIC_RELAXED, __HIP_MEMORY_SCOPE_AGENT);
        const int nv = (ce - ti * 16) < 16 ? (ce - ti * 16) : 16;
        __syncthreads();
        if (tid < 16) tks[tid] = tid < nv ? list[e * LISTCAP + ti * 16 + tid] : -1;
        __syncthreads();
        for (int i = tid; i < 16 * 512; i += 512) { const int t = i >> 9, c2 = i & 511; const int tk = tks[t];
            float a = 0.f, b2 = 0.f; if (tk >= 0) { const unsigned u = *(const unsigned*)(XN + (size_t)(tk >> 1) * DM + 2 * c2); a = bflo(u); b2 = bfhi(u); }
            xs[t * 1024 + 2 * c2] = a; xs[t * 1024 + 2 * c2 + 1] = b2; }
        __syncthreads();
        const int which = tid >> 8, f = tid & 255;
        const float* W = (which ? Wu : Wg) + (size_t)e * 1024 * 256 + f;
        float a16[16];
#pragma unroll
        for (int t = 0; t < 16; ++t) a16[t] = 0.f;
        for (int k = 0; k < 1024; k += 4) {
            const float w0 = W[(size_t)k * 256], w1 = W[(size_t)(k + 1) * 256], w2 = W[(size_t)(k + 2) * 256], w3 = W[(size_t)(k + 3) * 256];
#pragma unroll
            for (int t = 0; t < 16; ++t) { const f32x4 xv = *(const LAS f32x4*)(xs + t * 1024 + k); a16[t] += (xv.x * w0 + xv.y * w1) + (xv.z * w2 + xv.w * w3); }
        }
        if (which) {
#pragma unroll
            for (int t = 0; t < 16; ++t) hu[t * 256 + f] = a16[t];
        }
        __syncthreads();
        if (!which) {
#pragma unroll
            for (int t = 0; t < 16; ++t) { const int tk = tks[t]; const float p = tk >= 0 ? tokp[tk] : 0.f; const float gte = a16[t];
                act[t * 256 + f] = gte / (1.f + __expf(-gte)) * hu[t * 256 + f] * p; }
        }
        __syncthreads();
        float y0[16], y1[16];
#pragma unroll
        for (int t = 0; t < 16; ++t) { y0[t] = 0.f; y1[t] = 0.f; }
        const float* D0 = Wd + (size_t)e * 256 * 1024 + tid;
        for (int k = 0; k < 256; k += 4) {
            float wa[4], wb[4];
#pragma unroll
            for (int i = 0; i < 4; ++i) { wa[i] = D0[(size_t)(k + i) * 1024]; wb[i] = D0[(size_t)(k + i) * 1024 + 512]; }
#pragma unroll
            for (int t = 0; t < 16; ++t) { const f32x4 av = *(const LAS f32x4*)(act + t * 256 + k);
                y0[t] += (av.x * wa[0] + av.y * wa[1]) + (av.z * wa[2] + av.w * wa[3]); y1[t] += (av.x * wb[0] + av.y * wb[1]) + (av.z * wb[2] + av.w * wb[3]); }
        }
#pragma unroll
        for (int t = 0; t < 16; ++t) { const int tk = tks[t]; if (tk >= 0) { const int r = tk >> 1; float* hp = r < TR ? h0 + (size_t)r * DM : h1 + (size_t)(r - TR) * DM;
                hp[tid] += y0[t]; hp[tid + 512] += y1[t]; } }
    }
    __syncthreads();
}

__device__ __forceinline__ void ph_norm_kvq(const bf16* H, const float* gkv, const float* kv_w, const float* b_f, float* RS, float* logf, bf16* K, bf16* V,
                                            LAS unsigned char* lds, int vcu, int gw, int NGW, int tid, int lane, int wave) {
    for (int i = gw; i < 4 * 48; i += NGW) { bf16* base = (i & 1) ? V : K; const int bb = (i >> 1) & 1, rr = 16 + (i >> 2); v4u z = {0u, 0u, 0u, 0u};
        ((v4u*)(base + ((size_t)bb * KVROWS + rr) * DM))[2 * lane] = z; ((v4u*)(base + ((size_t)bb * KVROWS + rr) * DM))[2 * lane + 1] = z; }
    LAS bf16* Bl1 = (LAS bf16*)lds;
    LAS bf16* Bl2 = (LAS bf16*)(lds + 32768);
    LAS float* ssq = (LAS float*)(lds + 65536);
    LAS f32x4* part = (LAS f32x4*)(lds + 66560);
    for (int d = tid; d < 1024; d += 512) {
        const float gd = gkv[d];
#pragma unroll
        for (int q = 0; q < 4; ++q) { const f32x4 w4 = *(const f32x4*)(kv_w + (size_t)d * 2064 + 2048 + 4 * q);
#pragma unroll
            for (int e = 0; e < 4; ++e) { const float w = w4[e] * gd; const unsigned hi1 = f2bf(w); Bl1[(4 * q + e) * 1024 + d] = (bf16)hi1; Bl2[(4 * q + e) * 1024 + d] = (bf16)f2bf(w - __uint_as_float(hi1 << 16)); } }
    }
    __syncthreads();
    const int r16 = lane & 15, g4 = lane >> 4, kb = wave * 128 + 8 * g4;
    const int ntile = vcu == 0 ? 5 : 4;
    const float bfv = b_f[(tid >> 2) & 15];
    v4u hv[4];
    { const bf16* src = H + (size_t)(vcu * 64 + r16) * DM + kb;
#pragma unroll
      for (int ks = 0; ks < 4; ++ks) hv[ks] = *(const v4u*)(src + 32 * ks); }
#pragma unroll 1
    for (int it = 0; it < ntile; ++it) {
        const int R0 = it < 4 ? vcu * 64 + it * 16 : TR;
        v4u hn[4];
        { const bf16* srcn = H + (size_t)((it + 1 < 4 ? vcu * 64 + (it + 1) * 16 : TR) + r16) * DM + kb;
          if (it + 1 < ntile) {
#pragma unroll
              for (int ks = 0; ks < 4; ++ks) hn[ks] = *(const v4u*)(srcn + 32 * ks); }
          else {
#pragma unroll
              for (int ks = 0; ks < 4; ++ks) hn[ks] = hv[ks]; } }
        float ss = 0.f;
#pragma unroll
        for (int ks = 0; ks < 4; ++ks) ss += dot8bf(hv[ks], hv[ks]);
        ss += __shfl_xor(ss, 16); ss += __shfl_xor(ss, 32);
        if (g4 == 0) ssq[(it & 1) * 128 + wave * 16 + r16] = ss;
        f32x4 acc = {0.f, 0.f, 0.f, 0.f};
#pragma unroll
        for (int ks = 0; ks < 4; ++ks) {
            const rp_bf16x8 A1 = __builtin_bit_cast(rp_bf16x8, hv[ks]);
            const rp_bf16x8 B1 = *(const LAS rp_bf16x8*)(Bl1 + r16 * 1024 + kb + 32 * ks), B2 = *(const LAS rp_bf16x8*)(Bl2 + r16 * 1024 + kb + 32 * ks);
            acc = __builtin_amdgcn_mfma_f32_16x16x32_bf16(A1, B1, acc, 0, 0, 0);
            acc = __builtin_amdgcn_mfma_f32_16x16x32_bf16(A1, B2, acc, 0, 0, 0);
        }
        part[(it & 1) * 512 + wave * 64 + lane] = acc;
        LDS_BARRIER();
        if (tid < 256) { const int ln = tid >> 2, i = tid & 3, rr = 4 * (ln >> 4) + i, cc = ln & 15;
            float sacc = 0.f, q = 0.f;
#pragma unroll
            for (int w = 0; w < 8; ++w) { sacc += ((const LAS float*)(part + (it & 1) * 512))[(w * 64 + ln) * 4 + i]; q += ssq[(it & 1) * 128 + w * 16 + rr]; }
            const float rstd = rsqrtf(q * (1.f / DM) + 1e-6f);
            logf[(size_t)(R0 + rr) * 16 + cc] = log_sigmoidf(sacc * rstd + bfv);
            if (cc == 0) RS[R0 + rr] = rstd; }
#pragma unroll
        for (int ks = 0; ks < 4; ++ks) hv[ks] = hn[ks];
    }
}

__device__ __forceinline__ void headnorm_row(bf16* row, const float* g, float scale, int lane) {
    v4u a = ((v4u*)row)[2 * lane], b = ((v4u*)row)[2 * lane + 1];
    float f[16] = {bflo(a.x), bfhi(a.x), bflo(a.y), bfhi(a.y), bflo(a.z), bfhi(a.z), bflo(a.w), bfhi(a.w), bflo(b.x), bfhi(b.x), bflo(b.y), bfhi(b.y), bflo(b.z), bfhi(b.z), bflo(b.w), bfhi(b.w)};
    float ss = 0.f;
#pragma unroll
    for (int i = 0; i < 16; ++i) ss += f[i] * f[i];
    ss += __shfl_xor(ss, 1); ss += __shfl_xor(ss, 2);
    const float rstd = rsqrtf(ss * (1.f / 64.f) + 1e-6f) * scale;
    const float* gp = g + (lane & 3) * 16;
#pragma unroll
    for (int i = 0; i < 16; ++i) f[i] = f[i] * rstd * gp[i];
    a.x = pk2(f[0], f[1]); a.y = pk2(f[2], f[3]); a.z = pk2(f[4], f[5]); a.w = pk2(f[6], f[7]);
    b.x = pk2(f[8], f[9]); b.y = pk2(f[10], f[11]); b.z = pk2(f[12], f[13]); b.w = pk2(f[14], f[15]);
    ((v4u*)row)[2 * lane] = a; ((v4u*)row)[2 * lane + 1] = b;
}
__device__ __forceinline__ void ph_headnorm(bf16* Q, bf16* K, bf16* V, const float* gq, const float* gk, int gw, int NGW, int lane) {
    for (int r = gw; r < TR; r += NGW) headnorm_row(Q + (size_t)r * DM, gq, 0.125f * 1.4426950408889634f, lane);
    for (int i = gw; i < 4 * 48; i += NGW) { bf16* base = (i & 1) ? V : K; const int bb = (i >> 1) & 1, rr = 16 + (i >> 2); v4u z = {0u, 0u, 0u, 0u};
        ((v4u*)(base + ((size_t)bb * KVROWS + rr) * DM))[2 * lane] = z; ((v4u*)(base + ((size_t)bb * KVROWS + rr) * DM))[2 * lane + 1] = z; }
    for (int i = gw; i < NBATCH * LPOS; i += NGW) { const int b = i / LPOS, p = i % LPOS; const int kr = b * KVROWS + (p < NMETA ? p : 48 + p); headnorm_row(K + (size_t)kr * DM, gk, 1.f, lane); }
}

__device__ __forceinline__ void ph_attn_naive(const bf16* Q, const bf16* K, const bf16* V, const float* Fa, bf16* AO, int gw, int NGW, int lane) {
    for (int it = gw; it < NBATCH * 16 * SEQ; it += NGW) {
        const int h = it & 15, rt = it >> 4, b = rt / SEQ, t = rt % SEQ, p = NMETA + t;
        const float* Fb = Fa + (size_t)(b * 16 + h) * LPOS; const float Fq = Fb[p];
        v4u q[8];
#pragma unroll
        for (int i = 0; i < 8; ++i) q[i] = ((const v4u*)(Q + (size_t)rt * DM + h * 64))[i];
        float m = -3.0e38f, l = 0.f, acc = 0.f;
        const int nchunk = p / 64 + 1;
        for (int c = 0; c < nchunk; ++c) {
            const int s = c * 64 + lane; const bool valid = s <= p; const int sc = valid ? s : p;
            const size_t krow = (size_t)b * KVROWS + (sc < NMETA ? sc : 48 + sc);
            const v4u* kp = (const v4u*)(K + krow * DM + h * 64);
            float d = 0.f;
#pragma unroll
            for (int i = 0; i < 8; ++i) d += dot8bf(q[i], kp[i]);
            const float lg = valid ? d + Fq - Fb[sc] : -3.0e38f;
            const float mn = fmaxf(m, wave_max(lg));
            const float sc_old = __expf(m - mn);
            const float pv = valid ? __expf(lg - mn) : 0.f;
            l = l * sc_old + wave_sum(pv); acc *= sc_old; m = mn;
            const int jmax = (p - c * 64) < 63 ? (p - c * 64) : 63;
            for (int j = 0; j <= jmax; ++j) {
                const float pj = __shfl(pv, j); const int sj = c * 64 + j;
                const size_t vrow = (size_t)b * KVROWS + (sj < NMETA ? sj : 48 + sj);
                acc += pj * __uint_as_float((unsigned)V[vrow * DM + h * 64 + lane] << 16);
            }
        }
        AO[(size_t)rt * DM + h * 64 + lane] = (bf16)f2bf(acc / l);
    }
}

__device__ __forceinline__ void build_fk(const float* logf, int b, int h, LAS float* fk, LAS float* scr, int tid, int lane, int wave) {
    const int p0 = tid * 17;
    float loc[17]; float s = 0.f;
#pragma unroll
    for (int i = 0; i < 17; ++i) { const int p = p0 + i; float v = 0.f; if (p < LPOS) { const int row = p < NMETA ? TR + p : b * SEQ + p - NMETA; v = logf[(size_t)row * 16 + h]; } loc[i] = v; s += v; }
    float incl = s;
#pragma unroll
    for (int o = 1; o < 64; o <<= 1) { const float t = __shfl_up(incl, o); if (lane >= o) incl += t; }
    __syncthreads();
    if (lane == 63) scr[wave] = incl;
    __syncthreads();
    float base = 0.f;
#pragma unroll
    for (int w = 0; w < 8; ++w) base += (w < wave) ? scr[w] : 0.f;
    float run = base + incl - s;
#pragma unroll
    for (int i = 0; i < 17; ++i) { const int p = p0 + i; if (p < LPOS) { run += loc[i]; fk[p < NMETA ? p : p + 48] = run * 1.4426950408889634f; } }
    if (tid < 48) fk[16 + tid] = __builtin_inff();
    __syncthreads();
}

__device__ __forceinline__ void moe_tables(const gu32* cnt, LAS int* tbl, int tid) {
    __syncthreads();
    if (tid < 24) { const int c = (int)__hip_atomic_load(cnt + 32 * tid, __ATOMIC_RELAXED, __HIP_MEMORY_SCOPE_AGENT); tbl[tid] = (c + 255) >> 8; tbl[32 + tid] = c; }
    __syncthreads();
    if (tid < 128) { int b = -1, t0 = 0, accn = 0;
#pragma unroll 1
        for (int k = 0; k < 24; ++k) { const int n = tbl[k]; if (b < 0 && tid < accn + n) { b = k; t0 = tid - accn; } accn += n; }
        tbl[64 + tid] = b < 0 ? -1 : ((b << 16) | t0);
        if (tid == 0) tbl[60] = accn; }
    __syncthreads();
}

__device__ __forceinline__ void ph_final_add(float* out, const bf16* Y, int gw, int NGW, int lane) {
    for (int r = gw; r < TR; r += NGW) {
#pragma unroll
        for (int j = 0; j < 4; ++j) { const v2u yv = ((const v2u*)(Y + (size_t)r * DM))[lane + 64 * j];
            ((f32x4*)(out + (size_t)r * DM))[lane + 64 * j] += (f32x4){bflo(yv.x), bfhi(yv.x), bflo(yv.y), bfhi(yv.y)}; }
    }
}

__device__ __forceinline__ void ph_fk_scan(const float* logf, const float* gq, const float* gk, float* FK, int* TS, LAS unsigned char* lds, int bx, int tid, int lane, int wave) {
    if (bx < 32) {
        LAS float* scr = (LAS float*)lds;
        LAS int* tsl = (LAS int*)(lds + 128);
        LAS float* fl = (LAS float*)(lds + 1024);
        const int b = bx >> 4, h = bx & 15, p0 = tid * 17;
        float loc[17]; float s = 0.f;
#pragma unroll
        for (int i = 0; i < 17; ++i) { const int p = p0 + i; float v = 0.f; if (p < LPOS) { const int row = p < NMETA ? TR + p : b * SEQ + p - NMETA; v = logf[(size_t)row * 16 + h]; } loc[i] = v; s += v; }
        float incl = s;
#pragma unroll
        for (int o = 1; o < 64; o <<= 1) { const float t = __shfl_up(incl, o); if (lane >= o) incl += t; }
        __syncthreads();
        if (lane == 63) scr[wave] = incl;
        if (tid < 32) tsl[tid] = 1 << 20;
        if (wave == 1) { const float a = wave_max(fabsf(gq[lane])), c = wave_max(fabsf(gk[lane])); if (lane == 0) scr[16] = 40.f + 2.f * (11.5416f * 1.03f * a * c); }
        __syncthreads();
        float base = 0.f;
#pragma unroll
        for (int w = 0; w < 8; ++w) base += (w < wave) ? scr[w] : 0.f;
        float run = base + incl - s;
        float* fk = FK + (size_t)bx * KVROWS;
#pragma unroll
        for (int i = 0; i < 17; ++i) { const int p = p0 + i; if (p < LPOS) { run += loc[i]; const float v = run * 1.4426950408889634f; const int sl = p < NMETA ? p : p + 48; fk[sl] = v; fl[sl] = v; } }
        if (tid < 48) { fk[16 + tid] = __builtin_inff(); fl[16 + tid] = __builtin_inff(); }
        __syncthreads();
        const float thr = scr[16];
        for (int idx = tid; idx < 32 * 132; idx += 512) { const int qb = idx / 132, t = idx - qb * 132;
            if (t < 4 * qb + 5) { const float d = fl[64 + 256 * qb] - fl[t == 0 ? 15 : 64 * t + 63]; if (d >= -thr) atomicMin((int*)tsl + qb, t); } }
        __syncthreads();
        if (tid < 32) { int ts = tsl[tid]; const int lim = 4 * tid; ts = ts < lim ? ts : lim; TS[bx * 32 + tid] = ts & ~1; }
    }
}

constexpr int ML_NU = 260, ML_PX = 272, ML_PV = 560, ML_ST = 128 * 272;
typedef short bf16x8_t __attribute__((ext_vector_type(8)));
typedef short s16x4_t __attribute__((ext_vector_type(4)));
typedef short v4i16_t __attribute__((ext_vector_type(4)));

__device__ __forceinline__ bf16x8_t tr_frag(const LAS unsigned char* tile, int pitchB, int lane) {
    const LAS unsigned char* p = tile + (8 * (lane >> 4) + ((lane & 15) >> 2)) * pitchB + (lane & 3) * 8;
    const s16x4_t lo = __builtin_bit_cast(s16x4_t, __builtin_amdgcn_ds_read_tr16_b64_v4i16((LAS v4i16_t*)p));
    const s16x4_t hi = __builtin_bit_cast(s16x4_t, __builtin_amdgcn_ds_read_tr16_b64_v4i16((LAS v4i16_t*)(p + 4 * pitchB)));
    return (bf16x8_t){lo[0], lo[1], lo[2], lo[3], hi[0], hi[1], hi[2], hi[3]};
}
__device__ __forceinline__ v4u scale8(v4u a, float s) {
    v4u r; r.x = pk2(bflo(a.x) * s, bfhi(a.x) * s); r.y = pk2(bflo(a.y) * s, bfhi(a.y) * s); r.z = pk2(bflo(a.z) * s, bfhi(a.z) * s); r.w = pk2(bflo(a.w) * s, bfhi(a.w) * s); return r;
}
__device__ __forceinline__ float block_scan256(float v, LAS float* sc, int lane, int wave) {
    float incl = v;
#pragma unroll
    for (int o = 1; o < 64; o <<= 1) { const float t = __shfl_up(incl, o); if (lane >= o) incl += t; }
    __syncthreads();
    if (lane == 63) sc[wave] = incl;
    __syncthreads();
    float base = 0.f;
#pragma unroll
    for (int w = 0; w < 8; ++w) base += (w < wave) ? sc[w] : 0.f;
    return base + incl;
}
struct MlUnit { int h, rowbase, nvalid, meta; };
__device__ __forceinline__ int ml_unit_of(int i, int bx) {
    if (i) return 256 + bx;
    const int q = bx & 7, j = bx >> 3, pm = 8 * q + (j >> 2), h = j & 3;
    return ((pm >> 5) * 4 + h) * 32 + (pm & 31);
}
__device__ __forceinline__ MlUnit ml_unit(int u) {
    MlUnit m;
    if (u < 256) { const int bh = u >> 5, c = u & 31; m.h = bh & 3; m.rowbase = (bh >> 2) * SEQ + c * 256; m.nvalid = 256; m.meta = 0; }
    else { m.h = u - 256; m.rowbase = TR; m.nvalid = NMETA; m.meta = 1; }
    return m;
}

__device__ __forceinline__ void ml_kvloc(const bf16* PROJ, const float* gates, bf16* KV, float* Gt, LAS unsigned char* lds, int bx, int G, int tid, int lane, int wave) {
    LAS float* wgt = (LAS float*)lds;
    LAS float* sc = (LAS float*)(lds + 1024);
    LAS unsigned char* Xs = lds + 2048;
    LAS unsigned char* Vs = lds + 2048 + 64 * ML_PX;
    const int g4 = lane >> 4, c16 = lane & 15;
    for (int iu = 0; iu < (bx < 4 ? 2 : 1); ++iu) {
        const int u = ml_unit_of(iu, bx);
        const MlUnit m = ml_unit(u);
        float lfv = 0.f, igv = -__builtin_inff();
        if (tid < m.nvalid) { lfv = gates[(size_t)(m.rowbase + tid) * 8 + 4 + m.h]; igv = gates[(size_t)(m.rowbase + tid) * 8 + m.h]; }
        v4u kr[2], vr[4];
#pragma unroll
        for (int j = 0; j < 2; ++j) { const int i = tid + 512 * j, s = (i >> 4); kr[j] = (v4u){0u, 0u, 0u, 0u};
            if (s < m.nvalid) kr[j] = *(const v4u*)(PROJ + (size_t)(m.rowbase + s) * 3072 + 512 + m.h * 128 + (i & 15) * 8); }
#pragma unroll
        for (int j = 0; j < 4; ++j) { const int i = tid + 512 * j, s = (i >> 5); vr[j] = (v4u){0u, 0u, 0u, 0u};
            if (s < m.nvalid) vr[j] = *(const v4u*)(PROJ + (size_t)(m.rowbase + s) * 3072 + 1024 + m.h * 256 + (i & 31) * 8); }
        const float bc = block_scan256(tid < 256 ? lfv : 0.f, sc, lane, wave);
        __syncthreads();
        if (tid == 255) sc[8] = bc;
        __syncthreads();
        const float gtot = sc[8];
        if (tid < 256) wgt[tid] = (tid < m.nvalid) ? __expf(gtot - bc + igv) : 0.f;
        if (tid == 0) Gt[u] = gtot;
        f32x4 acc[17];
#pragma unroll
        for (int t = 0; t < 17; ++t) acc[t] = (f32x4){0.f, 0.f, 0.f, 0.f};
        const int nsb = (m.nvalid + 63) >> 6;
        for (int sb = 0; sb < nsb; ++sb) {
            LDS_BARRIER();
#pragma unroll
            for (int j = 0; j < 2; ++j) { const int i = tid + 512 * j; *(LAS v4u*)(Xs + (i >> 4) * ML_PX + (i & 15) * 16) = scale8(kr[j], wgt[sb * 64 + (i >> 4)]); }
#pragma unroll
            for (int j = 0; j < 4; ++j) { const int i = tid + 512 * j; *(LAS v4u*)(Vs + (i >> 5) * ML_PV + (i & 31) * 16) = vr[j]; }
            if (tid < 128) { const int row = tid >> 1, ch = tid & 1; const v4u o = {ch == 0 ? 0x3F80u : 0u, 0u, 0u, 0u}; *(LAS v4u*)(Vs + row * ML_PV + 512 + ch * 16) = o; }
            if (sb + 1 < nsb) {
#pragma unroll
                for (int j = 0; j < 2; ++j) { const int i = tid + 512 * j, s = (sb + 1) * 64 + (i >> 4); kr[j] = (v4u){0u, 0u, 0u, 0u};
                    if (s < m.nvalid) kr[j] = *(const v4u*)(PROJ + (size_t)(m.rowbase + s) * 3072 + 512 + m.h * 128 + (i & 15) * 8); }
#pragma unroll
                for (int j = 0; j < 4; ++j) { const int i = tid + 512 * j, s = (sb + 1) * 64 + (i >> 5); vr[j] = (v4u){0u, 0u, 0u, 0u};
                    if (s < m.nvalid) vr[j] = *(const v4u*)(PROJ + (size_t)(m.rowbase + s) * 3072 + 1024 + m.h * 256 + (i & 31) * 8); }
            }
            LDS_BARRIER();
#pragma unroll
            for (int ks = 0; ks < 2; ++ks) {
                const bf16x8_t a = tr_frag(Xs + (32 * ks) * ML_PX + (16 * wave) * 2, ML_PX, lane);
#pragma unroll
                for (int t = 0; t < 17; ++t) { const bf16x8_t bq = tr_frag(Vs + (32 * ks) * ML_PV + 32 * t, ML_PV, lane); acc[t] = __builtin_amdgcn_mfma_f32_16x16x32_bf16(a, bq, acc[t], 0, 0, 0);
                    if (t & 1) __builtin_amdgcn_sched_barrier(0); }
            }
        }
        { LAS unsigned char* Ot = lds + 55296 + wave * 8704;
#pragma unroll
          for (int t = 0; t < 17; ++t)
#pragma unroll
              for (int i = 0; i < 4; ++i) *(LAS unsigned short*)(Ot + (4 * g4 + i) * 544 + (16 * t + c16) * 2) = (unsigned short)f2bf(acc[t][i]);
          __builtin_amdgcn_sched_barrier(0);
          bf16* outw = KV + (size_t)u * ML_ST + (size_t)(16 * wave) * 272;
#pragma unroll
          for (int n = 0; n < 9; ++n) { const int q = lane + 64 * n; if (q < 544) *(v4u*)(outw + q * 8) = *(const LAS v4u*)(Ot + q * 16); } }
        __syncthreads();
    }
}

__device__ __forceinline__ void ml_scan(const bf16* __restrict__ KV, const float* __restrict__ Gt, bf16* __restrict__ Cin, int bx, int G, int tid) {
    for (int id = bx * 512 + tid; id < 8 * 128 * 68; id += G * 512) {
        const int bh = id / 8704, rem = id - bh * 8704, off = (rem / 68) * 272 + (rem % 68) * 4, h = bh & 3;
        f32x4 C = {0.f, 0.f, 0.f, 0.f};
#pragma unroll 4
        for (int c = 0; c < 32; ++c) {
            const int su = (c == 0) ? 256 + h : bh * 32 + c - 1;
            const v2u kr = *(const v2u*)(KV + (size_t)su * ML_ST + off); const f32x4 kv = {bflo(kr.x), bfhi(kr.x), bflo(kr.y), bfhi(kr.y)};
            const float e = __expf(Gt[su]);
            C = C * e + kv;
            *(unsigned long long*)(Cin + (size_t)(bh * 32 + c) * ML_ST + off) = pack4bf(C);
        }
    }
}

template <class BarFn>
__device__ __forceinline__ void ml_out(const bf16* PROJ, const float* gates, const bf16* Cin, const float* g_out, bf16* HM, LAS unsigned char* lds, int bx, int G, int tid, int lane, int wave, const BarFn& grid_barrier) {
    LAS unsigned char* Cs = lds;
    LAS unsigned char* Vs = lds + 71680;
    LAS unsigned char* Ks = lds + 107520;
    LAS float* bcs = (LAS float*)(lds + 124928);
    LAS float* igs = bcs + 256;
    LAS float* sc = igs + 256;
    LAS unsigned char* Ssc = lds + 127232 + wave * 1280;
    const int g4 = lane >> 4, c16 = lane & 15;
#pragma unroll 1
    for (int iu = 0; iu < 2; ++iu) {
        if (iu == 1) grid_barrier();
        const int u = iu == 0 ? (bx >= G - 4 ? 256 + (bx - (G - 4)) : -1) : ml_unit_of(0, bx);
        if (u < 0) continue;
        const MlUnit m = ml_unit(u);
        float lfv = 0.f, igv = -__builtin_inff();
        if (tid < m.nvalid) { lfv = gates[(size_t)(m.rowbase + tid) * 8 + 4 + m.h]; igv = gates[(size_t)(m.rowbase + tid) * 8 + m.h]; }
        const float bc = block_scan256(tid < 256 ? lfv : 0.f, sc, lane, wave);
        __syncthreads();
        if (tid < 256) { bcs[tid] = bc; igs[tid] = igv; }
        if (!m.meta) for (int i = tid; i < 128 * 34; i += 512) { const int row = i / 34, ch = i - row * 34;
            *(LAS v4u*)(Cs + row * ML_PV + ch * 16) = *(const v4u*)(Cin + (size_t)u * ML_ST + row * 272 + ch * 8); }
        __syncthreads();
        const int nkb = (m.nvalid + 63) >> 6;
#pragma unroll 1
        for (int x = 0; x < (m.meta ? 1 : 2); ++x) {
            const int rt = x ? 15 - wave : wave;
            bf16x8_t qa[4];
            { const bf16* src = PROJ + (size_t)(m.rowbase + 16 * rt + c16) * 3072 + m.h * 128 + 8 * g4;
#pragma unroll
              for (int ks = 0; ks < 4; ++ks) qa[ks] = *(const bf16x8_t*)(src + 32 * ks); }
            f32x4 acc[17];
#pragma unroll
            for (int t = 0; t < 17; ++t) acc[t] = (f32x4){0.f, 0.f, 0.f, 0.f};
            float br[4];
#pragma unroll
            for (int i = 0; i < 4; ++i) br[i] = bcs[16 * rt + 4 * g4 + i];
            v4u kr[2], vr[4];
#pragma unroll
            for (int j = 0; j < 2; ++j) { const int i = tid + 512 * j, s = (i >> 4); kr[j] = (v4u){0u, 0u, 0u, 0u};
                if (s < m.nvalid) kr[j] = *(const v4u*)(PROJ + (size_t)(m.rowbase + s) * 3072 + 512 + m.h * 128 + (i & 15) * 8); }
#pragma unroll
            for (int j = 0; j < 4; ++j) { const int i = tid + 512 * j, s = (i >> 5); vr[j] = (v4u){0u, 0u, 0u, 0u};
                if (s < m.nvalid) vr[j] = *(const v4u*)(PROJ + (size_t)(m.rowbase + s) * 3072 + 1024 + m.h * 256 + (i & 31) * 8); }
            if (!m.meta) {
                const float e0 = __expf(bcs[16 * rt + c16]);
#pragma unroll
                for (int ks = 0; ks < 4; ++ks) {
                    const bf16x8_t p0 = __builtin_bit_cast(bf16x8_t, scale8(__builtin_bit_cast(v4u, qa[ks]), e0));
#pragma unroll
                    for (int t = 0; t < 17; ++t) { const bf16x8_t bq = tr_frag(Cs + (32 * ks) * ML_PV + 32 * t, ML_PV, lane);
                        acc[t] = __builtin_amdgcn_mfma_f32_16x16x32_bf16(p0, bq, acc[t], 0, 0, 0);
                        if ((t & 3) == 3) __builtin_amdgcn_sched_barrier(0); }
                }
            }
            const int nkbx = x ? nkb : (nkb < 2 ? nkb : 2);
            for (int kb = 0; kb < nkbx; ++kb) {
                LDS_BARRIER();
#pragma unroll
                for (int j = 0; j < 2; ++j) { const int i = tid + 512 * j; *(LAS v4u*)(Ks + (i >> 4) * ML_PX + (i & 15) * 16) = kr[j]; }
#pragma unroll
                for (int j = 0; j < 4; ++j) { const int i = tid + 512 * j; *(LAS v4u*)(Vs + (i >> 5) * ML_PV + (i & 31) * 16) = vr[j]; }
                if (tid < 128) { const int row = tid >> 1, ch = tid & 1; const v4u o = {ch == 0 ? 0x3F80u : 0u, 0u, 0u, 0u}; *(LAS v4u*)(Vs + row * ML_PV + 512 + ch * 16) = o; }
                if (kb + 1 < nkbx) {
#pragma unroll
                    for (int j = 0; j < 2; ++j) { const int i = tid + 512 * j, s = (kb + 1) * 64 + (i >> 4); kr[j] = (v4u){0u, 0u, 0u, 0u};
                        if (s < m.nvalid) kr[j] = *(const v4u*)(PROJ + (size_t)(m.rowbase + s) * 3072 + 512 + m.h * 128 + (i & 15) * 8); }
#pragma unroll
                    for (int j = 0; j < 4; ++j) { const int i = tid + 512 * j, s = (kb + 1) * 64 + (i >> 5); vr[j] = (v4u){0u, 0u, 0u, 0u};
                        if (s < m.nvalid) vr[j] = *(const v4u*)(PROJ + (size_t)(m.rowbase + s) * 3072 + 1024 + m.h * 256 + (i & 31) * 8); }
                }
                LDS_BARRIER();
#pragma unroll
                for (int hb = 0; hb < 2; ++hb) {
                    const int s0 = 64 * kb + 32 * hb;
                    if (s0 > 16 * rt + 15) continue;
                    f32x4 sa[2] = {{0.f, 0.f, 0.f, 0.f}, {0.f, 0.f, 0.f, 0.f}};
#pragma unroll
                    for (int ks = 0; ks < 4; ++ks)
#pragma unroll
                        for (int n = 0; n < 2; ++n) { const bf16x8_t bk = *(const LAS bf16x8_t*)(Ks + (32 * hb + 16 * n + c16) * ML_PX + (32 * ks + 8 * g4) * 2);
                            sa[n] = __builtin_amdgcn_mfma_f32_16x16x32_bf16(qa[ks], bk, sa[n], 0, 0, 0); }
#pragma unroll
                    for (int n = 0; n < 2; ++n) { const int s = s0 + 16 * n + c16; const float bs = igs[s] - bcs[s];
#pragma unroll
                        for (int i = 0; i < 4; ++i) { const int r = 16 * rt + 4 * g4 + i; const float e = __expf(br[i] + bs); const float d = (s <= r) ? e : 0.f;
                            *(LAS unsigned short*)(Ssc + (4 * g4 + i) * 80 + (16 * n + c16) * 2) = (unsigned short)(f2bf(sa[n][i] * d)); } }
                    __builtin_amdgcn_sched_barrier(0);
                    const bf16x8_t pf = *(const LAS bf16x8_t*)(Ssc + c16 * 80 + 16 * g4);
#pragma unroll
                    for (int t = 0; t < 17; ++t) { const bf16x8_t bq = tr_frag(Vs + (32 * hb) * ML_PV + 32 * t, ML_PV, lane);
                        acc[t] = __builtin_amdgcn_mfma_f32_16x16x32_bf16(pf, bq, acc[t], 0, 0, 0);
                        if ((t & 3) == 3) __builtin_amdgcn_sched_barrier(0); }
                }
            }
            v4u ovr[2][4];
#pragma unroll
            for (int hf = 0; hf < 2; ++hf)
#pragma unroll
                for (int j = 0; j < 4; ++j) { const int chunk = j * 64 + lane, tr = 16 * rt + (chunk >> 4); ovr[hf][j] = (v4u){0u, 0u, 0u, 0u};
                    if (tr < m.nvalid) ovr[hf][j] = *(const v4u*)(PROJ + (size_t)(m.rowbase + tr) * 3072 + 2048 + m.h * 256 + hf * 128 + (chunk & 15) * 8); }
            LDS_BARRIER();
            LAS unsigned char* Ost = Vs + wave * 4352;
            float inv[4], ss[4];
#pragma unroll
            for (int i = 0; i < 4; ++i) { const float den = __shfl(acc[16][i], lane & 48); inv[i] = 1.f / fmaxf(fabsf(den), 1.f); ss[i] = 0.f; }
#pragma unroll
            for (int t = 0; t < 16; ++t)
#pragma unroll
                for (int i = 0; i < 4; ++i) { const float hv = acc[t][i] * inv[i]; acc[t][i] = hv; ss[i] += hv * hv; }
#pragma unroll
            for (int i = 0; i < 4; ++i) { float q = ss[i]; q += __shfl_xor(q, 1); q += __shfl_xor(q, 2); q += __shfl_xor(q, 4); q += __shfl_xor(q, 8); ss[i] = rsqrtf(q * (1.f / 256.f) + 1e-6f); }
#pragma unroll
            for (int hf = 0; hf < 2; ++hf) {
#pragma unroll
                for (int t8 = 0; t8 < 8; ++t8) { const int t = hf * 8 + t8; const float gg = g_out[m.h * 256 + 16 * t + c16];
#pragma unroll
                    for (int i = 0; i < 4; ++i) *(LAS unsigned short*)(Ost + (4 * g4 + i) * 272 + (16 * t8 + c16) * 2) = (unsigned short)f2bf(acc[t][i] * ss[i] * gg); }
                __builtin_amdgcn_sched_barrier(0);
#pragma unroll
                for (int j = 0; j < 4; ++j) { const int chunk = j * 64 + lane, row = chunk >> 4, ch = chunk & 15, tr = 16 * rt + row;
                    const v4u hv = *(const LAS v4u*)(Ost + row * 272 + ch * 16);
                    if (tr < m.nvalid) {
                        const v4u ov = ovr[hf][j];
                        v4u o;
                        o.x = pk2(bflo(hv.x) / (1.f + __expf(-bflo(ov.x))), bfhi(hv.x) / (1.f + __expf(-bfhi(ov.x))));
                        o.y = pk2(bflo(hv.y) / (1.f + __expf(-bflo(ov.y))), bfhi(hv.y) / (1.f + __expf(-bfhi(ov.y))));
                        o.z = pk2(bflo(hv.z) / (1.f + __expf(-bflo(ov.z))), bfhi(hv.z) / (1.f + __expf(-bfhi(ov.z))));
                        o.w = pk2(bflo(hv.w) / (1.f + __expf(-bflo(ov.w))), bfhi(hv.w) / (1.f + __expf(-bfhi(ov.w))));
                        *(v4u*)(HM + (size_t)(m.rowbase + tr) * DM + m.h * 256 + hf * 128 + ch * 8) = o;
                    }
                }
                __builtin_amdgcn_sched_barrier(0);
            }
        }
    }
    __syncthreads();
}

template <class EpiFn>
__device__ __forceinline__ void skinny_gemm16(const bf16* A16, const bf16* Bt, int ntask, LAS unsigned char* lds, int bx, int G, int tid, int lane, int wave, const EpiFn& epi) {
    LAS f32x4* part = (LAS f32x4*)lds;
    const int c16 = lane & 15, g4 = lane >> 4;
    for (int task = bx; task < ntask; task += G) {
        const int n0 = task * 64;
        f32x4 acc[4];
#pragma unroll
        for (int t = 0; t < 4; ++t) acc[t] = (f32x4){0.f, 0.f, 0.f, 0.f};
        const bf16* ap = A16 + (size_t)c16 * 1024 + wave * 128 + 8 * g4;
        const bf16* bp = Bt + (size_t)(n0 + c16) * 1024 + wave * 128 + 8 * g4;
#pragma unroll
        for (int ks = 0; ks < 4; ++ks) {
            const bf16x8_t a = *(const bf16x8_t*)(ap + 32 * ks);
#pragma unroll
            for (int t = 0; t < 4; ++t) { const bf16x8_t b = *(const bf16x8_t*)(bp + (size_t)t * 16 * 1024 + 32 * ks); acc[t] = __builtin_amdgcn_mfma_f32_16x16x32_bf16(b, a, acc[t], 0, 0, 0); }
        }
        __syncthreads();
#pragma unroll
        for (int t = 0; t < 4; ++t) part[(wave * 4 + t) * 64 + lane] = acc[t];
        __syncthreads();
        if (wave == 0) {
#pragma unroll
            for (int t = 0; t < 4; ++t) { f32x4 s = part[t * 64 + lane];
#pragma unroll
                for (int w = 1; w < 8; ++w) s += part[(w * 4 + t) * 64 + lane];
                acc[t] = s; }
            epi(c16, n0, g4, acc);
        }
    }
    __syncthreads();
}

struct Args { const float* in[22]; float* out; unsigned char* ws; int ph_lo, ph_hi, li, pad; };
__global__ void __launch_bounds__(NWAVES * 64, 2) trunk_fwd(Args args) {
    extern __shared__ __attribute__((aligned(16))) unsigned char lds_raw[];
    LAS unsigned char* lds = (LAS unsigned char*)lds_raw;
    volatile LAS unsigned* MISC = (volatile LAS unsigned*)(lds + MISC_OFF);
    const int tid = threadIdx.x, lane = tid & 63, wave = __builtin_amdgcn_readfirstlane(tid >> 6);
    const int G = gridDim.x; const int bx = blockIdx.x; const int vcu = (G % 8 == 0) ? (bx % 8) * (G / 8) + bx / 8 : bx;
    const int gw = vcu * NWAVES + wave, NGW = G * NWAVES;
    unsigned char* ws = args.ws;
    gu32* ctl = (gu32*)(ws + WS_CTL);
    const float* x = args.in[0]; const float* meta = args.in[1]; const float* norm_mix = args.in[2]; const float* norm_ffn = args.in[3];
    const float* m_w_in = args.in[4]; const float* m_b_gate = args.in[5]; const float* m_g_out = args.in[6]; const float* m_w_out = args.in[7];
    const float* kv_norm = args.in[8]; const float* kv_w = args.in[9]; const float* kv_b_f = args.in[10]; const float* k_norm = args.in[11];
    const float* f_w_q = args.in[12]; const float* f_q_norm = args.in[13]; const float* f_w_o = args.in[14];
    const float* moe_w_group = args.in[15]; const float* moe_b_group = args.in[16]; const float* moe_w_router = args.in[17]; const float* moe_b_router = args.in[18];
    const float* moe_w_gate = args.in[19]; const float* moe_w_up = args.in[20]; const float* moe_w_down = args.in[21];
    float* out = args.out;
    bf16* Win_t = (bf16*)(ws + WS_WIN); bf16* Wout_t = (bf16*)(ws + WS_WOUT); bf16* Wkv_t = (bf16*)(ws + WS_WKV); bf16* Wq_t = (bf16*)(ws + WS_WQ); bf16* Wo_t = (bf16*)(ws + WS_WO);
    float* gates = (float*)(ws + WS_GATES); float* RS = (float*)(ws + WS_RS); float* LP = (float*)(ws + WS_Q);
    float* Fm = (float*)(ws + WS_FM); float* Fa = (float*)(ws + WS_FA); float* logf = (float*)(ws + WS_LOGF); int* list = (int*)(ws + WS_LIST);
    bf16* XN = (bf16*)(ws + WS_XN); bf16* PROJ = (bf16*)(ws + WS_PROJ); bf16* H1 = (bf16*)(ws + WS_H1); bf16* H2 = XN; bf16* H3 = H1;
    bf16* CinB = (bf16*)(ws + WS_CIN); bf16* KVL = (bf16*)(ws + WS_KVL); bf16* W1t = (bf16*)(ws + WS_W1T); bf16* W2t = (bf16*)(ws + WS_W2T); bf16* ACT = (bf16*)(ws + WS_ACT); LAS int* mtbl = (LAS int*)(lds + LDSCTL_OFF + 1024);
    bf16* Kb = (bf16*)(ws + WS_K); bf16* Vb = (bf16*)(ws + WS_V); bf16* Qb = (bf16*)(ws + WS_Q); bf16* AO = (bf16*)(ws + WS_AO);

    for (int u = tid; u < (LDS_BYTES - LDSCTL_OFF) / 4; u += NWAVES * 64) ((LAS unsigned*)(lds + LDSCTL_OFF))[u] = 0u;
    __syncthreads();
    XcdBarrier bar; bar.bar = (unsigned*)(ctl + CW_BAR); bar.x = 0; bar.st = nullptr;
    if (N_LAUNCHES == 1) bar = xcd_barrier_post((unsigned*)(ctl + CW_BAR), MISC + 8);
    const int lo = args.ph_lo, hi = args.ph_hi;
#ifndef PHASE_MASK
#define PHASE_MASK 0xFFFFF
#endif
#define IN(k) (((PHASE_MASK >> (k)) & 1) && lo <= (k) && (k) < hi)
#define SEAM(k) do { if (IN(k) && IN((k) + 1)) xcd_barrier(bar); } while (0)

    const TrPtrs TP{m_w_in, m_w_out, kv_w, f_w_q, f_w_o, moe_w_gate, moe_w_up, moe_w_down, kv_norm, norm_mix + DM, norm_ffn, Win_t, Wout_t, Wkv_t, Wq_t, Wo_t, W1t, W2t};
    if (IN(0)) { ph_prologue(x, meta, norm_mix, m_w_in, m_b_gate, TP, XN, gates, lds, gw, NGW, tid, lane, wave); }
    SEAM(0);
    if (IN(1)) {
        skinny_gemm16(XN + (size_t)TR * DM, Win_t, 48, lds, bx, G, tid, lane, wave, [&](int row, int n0, int g4, const f32x4 (&v)[4]) {
            const float sc = n0 < 512 ? 0.08838834764831845f : 1.f;
#pragma unroll
            for (int t = 0; t < 4; ++t) *(unsigned long long*)(PROJ + (size_t)(TR + row) * 3072 + n0 + 16 * t + 4 * g4) = pack4bf(v[t] * sc); });
        pg8::Gemm g{XN, Win_t, TR, 3072, 1024}; pg8::StaticOrder S; S.init(TR, 3072, G, bx);
        pg8::EpiBf16<0> E{PROJ, 3072, nullptr, 512, 512, 0.08838834764831845f};
        pg8::gemm_phase<pg8::EpiBf16<0>, pg8::StaticOrder, true, true>(lds + RING_OFF, g, S, E);
    }
    SEAM(1);
    if (IN(2)) { ml_kvloc(PROJ, gates, KVL, Fm, lds, bx, G, tid, lane, wave); }
    SEAM(2);
    if (IN(3)) { ml_scan(KVL, Fm, CinB, bx, G, tid); ml_out(PROJ, gates, CinB, m_g_out, XN, lds, bx, G, tid, lane, wave, [&]() { xcd_barrier(bar); }); }
    SEAM(3);
    if (IN(4)) {
        skinny_gemm16(XN + (size_t)TR * DM, Wout_t, 16, lds, bx, G, tid, lane, wave, [&](int row, int n0, int g4, const f32x4 (&v)[4]) {
#pragma unroll
            for (int t = 0; t < 4; ++t) { const int c = n0 + 16 * t + 4 * g4; *(unsigned long long*)(H1 + (size_t)(TR + row) * DM + c) = pack4bf(*(const f32x4*)(meta + (size_t)row * DM + c) + v[t]); } });
        pg8::Gemm g{XN, Wout_t, TR, 1024, 1024}; pg8::StaticOrder S; S.init(TR, 1024, G, bx);
        pg8::EpiResB<false> E{x, H1};
        pg8::gemm_phase<pg8::EpiResB<false>, pg8::StaticOrder, true, true>(lds + RING_OFF, g, S, E);
    }
    SEAM(4);
    if (IN(5)) { ph_norm_router(H1, TALL, norm_ffn, moe_w_group, moe_b_group, moe_w_router, moe_b_router, LP, ctl + CW_CNT, list, lds, vcu, tid, lane, wave); }
    SEAM(5);
    if (IN(6)) {
        moe_tables(ctl + CW_CNT, mtbl, tid);
        { pg8::MoeSched<1> S{mtbl, list, (const char*)W1t, G, vcu, (unsigned*)(ctl + CW_RDY)}; pg8::Gemm2 g{(const char*)H1, 1024, 1024}; pg8::EpiMoe1 E{ACT, LP};
          pg8::gemm_phase2<pg8::EpiMoe1, pg8::MoeSched<1>>(lds + RING_OFF, (LAS unsigned*)(lds + LDSCTL_OFF + 2048), g, S, E); }
        { pg8::MoeSched<2> S{mtbl, list, (const char*)W2t, G, vcu, (unsigned*)(ctl + CW_RDY)}; pg8::Gemm2 g{(const char*)ACT, 512, 8192}; pg8::EpiMoe2R<false> E{H1, H2, list};
          pg8::gemm_phase2<pg8::EpiMoe2R<false>, pg8::MoeSched<2>>(lds + RING_OFF, (LAS unsigned*)(lds + LDSCTL_OFF + 2048), g, S, E); }
    }
    SEAM(6);
    if (IN(7)) { ph_norm_kvq(H2, kv_norm, kv_w, kv_b_f, RS, logf, Kb, Vb, lds, vcu, gw, NGW, tid, lane, wave); }
    SEAM(7);
    if (IN(8)) {
        skinny_gemm16(H2 + (size_t)TR * DM, Wkv_t, 32, lds, bx, G, tid, lane, wave, [&](int row, int n0, int g4, const f32x4 (&v)[4]) {
            const bool isK = n0 < 1024; bf16* base = isK ? Kb : Vb; const int cb = isK ? n0 : n0 - 1024;
            float rstd = RS[TR + row];
            if (isK) { float ss = 0.f;
#pragma unroll
                for (int t = 0; t < 4; ++t) ss += dot4(v[t], v[t]);
                ss += __shfl_xor(ss, 16); ss += __shfl_xor(ss, 32); rstd = rstd * rsqrtf(ss * (rstd * rstd * (1.f / 64.f)) + 1e-6f); }
#pragma unroll
            for (int t = 0; t < 4; ++t) { f32x4 o = v[t] * rstd; if (isK) o = o * *(const f32x4*)(k_norm + 16 * t + 4 * g4);
                const unsigned long long w = pack4bf(o);
                *(unsigned long long*)(base + (size_t)row * DM + cb + 16 * t + 4 * g4) = w; *(unsigned long long*)(base + (size_t)(KVROWS + row) * DM + cb + 16 * t + 4 * g4) = w; } });
        { pg8::Gemm g{H2, Wkv_t, TR, 2048, 1024}; pg8::StaticOrder S; S.init(TR, 2048, G, bx);
          pg8::EpiKVN E{Kb, Vb, k_norm, RS};
          pg8::gemm_phase<pg8::EpiKVN, pg8::StaticOrder, true, true>(lds + RING_OFF, g, S, E); }
        { pg8::Gemm g{H2, Wq_t, TR, 1024, 1024}; pg8::StaticOrder S; S.init(TR, 1024, G, bx);
          static_assert(WS_Q - WS_RS == pg8::X_Q_TO_RS, "EpiQN finds the row scales relative to Qb");
          pg8::EpiQN E{Qb, f_q_norm, 0.125f * 1.4426950408889634f};
          pg8::gemm_phase<pg8::EpiQN, pg8::StaticOrder, true, true>(lds + RING_OFF, g, S, E); }
    }
    SEAM(8);
    if (IN(9)) { ph_fk_scan(logf, f_q_norm, k_norm, Fa, (int*)(Fa + 32 * KVROWS), lds, bx, tid, lane, wave);
        if (bx >= 32) ph_transposes<1>(TP, (LAS float*)(lds + 32768 + wave * 8704), (bx - 32) * NWAVES + wave, (G - 32) * NWAVES, lane); }
    SEAM(9);
    if (IN(10)) {
        LAS float* fkl = (LAS float*)(lds + 86016);
        LAS int* keys = (LAS int*)(lds + 119040);
        LAS int* sinf = (LAS int*)(lds + 127232);
        LAS float* fq = (LAS float*)(lds + 131328);
        LAS int* scn = (LAS int*)(lds + 132352);
        const int* TS = (const int*)(Fa + 32 * KVROWS);
        float* pscr = (float*)(ws + WS_H1);
        { int tsv[2], fl[2], cnt2 = 0;
#pragma unroll
          for (int j = 0; j < 2; ++j) { const int i = 2 * tid + j; tsv[j] = TS[i]; fl[j] = (4 * (i & 31) + 5 - tsv[j]) >= 71 ? 1 : 0; cnt2 += fl[j]; }
          int incl = cnt2;
#pragma unroll
          for (int o = 1; o < 64; o <<= 1) { const int t = __shfl_up(incl, o); if (lane >= o) incl += t; }
          if (lane == 63) scn[wave] = incl;
          __syncthreads();
          int base = 0;
#pragma unroll
          for (int w = 0; w < 8; ++w) base += (w < wave) ? scn[w] : 0;
          int run = base + incl - cnt2;
#pragma unroll
          for (int j = 0; j < 2; ++j) { const int i = 2 * tid + j, c = 4 * (i & 31) + 5 - tsv[j]; const bool sp = fl[j] && run < 236;
              sinf[i] = (run << 8) | tsv[j];
              if (sp) { const int cA = ((c - 4) >> 1) & ~1; keys[2 * i] = ((cA + 1) << 12) | (1 << 10) | i; keys[2 * i + 1] = ((c - cA) << 12) | (2 << 10) | i; }
              else { keys[2 * i] = (c << 12) | i; keys[2 * i + 1] = 0; }
              run += fl[j]; } }
        { int kv[4];
          __syncthreads();
#pragma unroll
          for (int e = 0; e < 4; ++e) kv[e] = keys[4 * tid + e];
#pragma unroll
          for (int kk = 2; kk <= 2048; kk <<= 1) {
#pragma unroll
              for (int j = kk >> 1; j > 0; j >>= 1) {
                  if (j >= 256) {
                      LDS_BARRIER();
#pragma unroll
                      for (int e = 0; e < 4; ++e) keys[4 * tid + e] = kv[e];
                      LDS_BARRIER();
#pragma unroll
                      for (int e = 0; e < 4; ++e) { const int i = 4 * tid + e, p = keys[i ^ j]; const bool up = ((i & j) == 0) == ((i & kk) == 0); kv[e] = up ? max(kv[e], p) : min(kv[e], p); }
                  } else if (j >= 4) {
#pragma unroll
                      for (int e = 0; e < 4; ++e) { const int i = 4 * tid + e, p = __shfl_xor(kv[e], j >> 2); const bool up = ((i & j) == 0) == ((i & kk) == 0); kv[e] = up ? max(kv[e], p) : min(kv[e], p); }
                  } else {
#pragma unroll
                      for (int e = 0; e < 4; ++e) if ((e & j) == 0) { const int a = kv[e], b = kv[e | j]; const bool desc = ((4 * tid + e) & kk) == 0; const int hi = max(a, b), lo = min(a, b); kv[e] = desc ? hi : lo; kv[e | j] = desc ? lo : hi; }
                  }
              }
          }
          LDS_BARRIER();
#pragma unroll
          for (int e = 0; e < 4; ++e) keys[4 * tid + e] = kv[e]; }
        __syncthreads();
#pragma unroll 1
        for (int kq = 0; kq < 8; ++kq) {
            const int idx = (kq & 1) ? kq * 256 + 255 - vcu : kq * 256 + vcu;
            const int key = __builtin_amdgcn_readfirstlane(keys[idx]);
            if (key == 0) break;
            const int unit = key & 1023, part = (key >> 10) & 3, cost = key >> 12, bh = unit >> 5, qb = unit & 31;
            const int si = __builtin_amdgcn_readfirstlane(sinf[unit]), ts = si & 255, sj = si >> 8, c = 4 * qb + 5 - ts, cA = ((c - 4) >> 1) & ~1;
            const int tile0 = part == 2 ? ts + cA : ts;
            const float* fkg = Fa + (size_t)bh * KVROWS;
            __syncthreads();
            {
#pragma unroll 1
              for (int i = 4 * tid; i < 64 * cost; i += 2048) {
                  f32x4 f0 = *(const f32x4*)(fkg + 64 * tile0 + i);
                  if (part == 1 && i >= 64 * cA) f0 = (f32x4){__builtin_inff(), __builtin_inff(), __builtin_inff(), __builtin_inff()};
                  *(LAS f32x4*)(fkl + i) = f0; }
              if (tid < 256) fq[tid] = fkg[64 + 256 * qb + tid]; }
            __syncthreads();
            attn_body::attn_unit<12>(bh >> 4, bh & 15, qb, (const attn_body::bf16*)Qb, (const attn_body::bf16*)Kb, (const attn_body::bf16*)Vb, (attn_body::bf16*)AO, (char*)lds_raw + RING_OFF,
                                     fkl, fq, tile0, cost, part != 1, part ? pscr + (size_t)(2 * sj + part - 1) * (8 * 33 * 64) : (float*)nullptr);
        }
        xcd_barrier(bar);
        for (int i = tid; i < 1024; i += 512) { const int si = sinf[i]; if ((4 * (i & 31) + 5 - (si & 255)) >= 71 && (si >> 8) < 236) keys[si >> 8] = i; }
        __syncthreads();
        const int nsplit = __builtin_amdgcn_readfirstlane(scn[7] + 0 * tid) ;
        { int tot = 0;
#pragma unroll
          for (int w = 0; w < 8; ++w) tot += scn[w];
          const int ns = tot < 236 ? tot : 236;
          for (int sj = vcu; sj < ns; sj += G) {
              const int unit = __builtin_amdgcn_readfirstlane(keys[sj]), bh = unit >> 5, qb = unit & 31;
              const float* pa = pscr + (size_t)(2 * sj) * (8 * 33 * 64) + (size_t)wave * 33 * 64 + lane; const float* pb = pa + 8 * 33 * 64;
              attn_body::f32x16 o[2]; float l;
#pragma unroll
              for (int d0 = 0; d0 < 2; ++d0)
#pragma unroll
                  for (int r = 0; r < 16; ++r) o[d0][r] = pa[(d0 * 16 + r) * 64] + pb[(d0 * 16 + r) * 64];
              l = pa[32 * 64] + pb[32 * 64];
              attn_body::attn_finish(o, l, (attn_body::bf16*)AO + ((size_t)(bh >> 4) * SEQ + qb * 256 + wave * 32) * DM + (bh & 15) * 64, (char*)lds_raw + RING_OFF, wave, lane);
              asm volatile("s_waitcnt lgkmcnt(0)\n\ts_barrier" ::: "memory");
          } }
        (void)nsplit;
    }
    SEAM(10);
    if (IN(11)) {
        pg8::Gemm g{AO, Wo_t, TR, 1024, 1024}; pg8::StaticOrder S; S.init(TR, 1024, G, bx);
        pg8::EpiResB<true> E{H2, H3};
        pg8::gemm_phase<pg8::EpiResB<true>, pg8::StaticOrder, true, true>(lds + RING_OFF, g, S, E);
    }
    SEAM(11);
    if (IN(12)) { ph_norm_router(H3, TR, norm_ffn + DM, moe_w_group + 4096, moe_b_group + 4, moe_w_router + 16384, moe_b_router + 16, LP, ctl + CW_CNT + 1024, list, lds, vcu, tid, lane, wave); }
    SEAM(12);
    if (IN(13)) {
        moe_tables(ctl + CW_CNT + 1024, mtbl, tid);
        { pg8::MoeSched<1> S{mtbl, list, (const char*)(W1t + (size_t)16 * 512 * 1024), G, vcu, (unsigned*)(ctl + CW_RDY + 8192)}; pg8::Gemm2 g{(const char*)H3, 1024, 1024}; pg8::EpiMoe1 E{ACT, LP};
          pg8::gemm_phase2<pg8::EpiMoe1, pg8::MoeSched<1>>(lds + RING_OFF, (LAS unsigned*)(lds + LDSCTL_OFF + 2048), g, S, E); }
        { pg8::MoeSched<2> S{mtbl, list, (const char*)(W2t + (size_t)1024 * 8192), G, vcu, (unsigned*)(ctl + CW_RDY + 8192)}; pg8::Gemm2 g{(const char*)ACT, 512, 8192}; pg8::EpiMoe2R<true> E{H3, out, list};
          pg8::gemm_phase2<pg8::EpiMoe2R<true>, pg8::MoeSched<2>>(lds + RING_OFF, (LAS unsigned*)(lds + LDSCTL_OFF + 2048), g, S, E); }
    }
#undef IN
#undef SEAM
}

extern "C" void kernel_launch(void* const* d_in, const int* in_sizes, int n_in, void* d_out, int out_size, void* d_ws, size_t ws_size, hipStream_t stream) {
    static int grid = 0;
    if (grid == 0) {
        int dev = 0, cus = 0, per_cu = 0;
        if (hipGetDevice(&dev) != hipSuccess || hipDeviceGetAttribute(&cus, hipDeviceAttributeMultiprocessorCount, dev) != hipSuccess) { fprintf(stderr, "kernel_launch: device query failed\n"); grid = -1; return; }
        if (hipFuncSetAttribute((const void*)trunk_fwd, hipFuncAttributeMaxDynamicSharedMemorySize, LDS_BYTES) != hipSuccess) { fprintf(stderr, "kernel_launch: hipFuncSetAttribute failed\n"); grid = -1; return; }
        if (hipOccupancyMaxActiveBlocksPerMultiprocessor(&per_cu, (const void*)trunk_fwd, NWAVES * 64, LDS_BYTES) != hipSuccess || per_cu < 1)
            fprintf(stderr, "kernel_launch: note: occupancy query reports %d workgroups per CU\n", per_cu);
        (void)hipGetLastError();
        grid = cus;
    }
    if (grid < 0) return;
    if (hipMemsetAsync((char*)d_ws + WS_CTL, 0, CTL_ZERO_BYTES, stream) != hipSuccess) { fprintf(stderr, "kernel_launch: memset failed\n"); return; }
    Args a{};
    for (int i = 0; i < 22; ++i) a.in[i] = (const float*)d_in[i];
    a.out = (float*)d_out; a.ws = (unsigned char*)d_ws;
    if (N_LAUNCHES == 1) { a.ph_lo = 0; a.ph_hi = NPHASE; a.li = 0; hipLaunchKernelGGL(trunk_fwd, dim3(grid), dim3(NWAVES * 64), LDS_BYTES, stream, a); }
    else for (int li = 0; li < NPHASE; ++li) { a.ph_lo = li; a.ph_hi = li + 1; a.li = li; hipLaunchKernelGGL(trunk_fwd, dim3(grid), dim3(NWAVES * 64), LDS_BYTES, stream, a); }
    const hipError_t le = hipPeekAtLastError();
    if (le != hipSuccess) fprintf(stderr, "kernel_launch: launch failed: %s\n", hipGetErrorName(le));
}
```

```cpp
#include <hip/hip_runtime.h>
#include <cstdio>
#include <cstdint>
namespace pg8 {
#define PG8_LAS __attribute__((address_space(3)))
typedef unsigned short bf16_t;
typedef short bf16x8 __attribute__((ext_vector_type(8)));
typedef float f32x4 __attribute__((ext_vector_type(4)));
typedef unsigned u32x4 __attribute__((ext_vector_type(4)));
constexpr int BM = 256, BK = 64, HALF = 128, HTB = HALF * BK * 2  , STAGE_BYTES = 8 * HTB, NXCD = 8, WGM = 8;

__host__ __device__ __forceinline__ int lds_byte(int r, int c) { const int st = (r >> 4) * 2 + (c >> 5), rr = r & 15, cc = c & 31, ob = rr * 64 + cc * 2; return st * 1024 + (ob ^ (((ob >> 9) & 1) << 5)); }
__host__ __device__ __forceinline__ void stage_rc(int b, int& R, int& C) { const int st = b / 1024, sb = b % 1024, swz = sb ^ (((sb >> 9) & 1) << 5); R = (st >> 1) * 16 + swz / 64; C = (st & 1) * 32 + (swz % 64) / 2; }
__host__ __device__ __forceinline__ int perm32(int rho) { const int n = rho >> 4, i = rho & 15; return 8 * (i >> 2) + 4 * n + (i & 3); }

struct Unit { int pm, pn; };
struct Gemm { const bf16_t* A; const bf16_t* Bt; int M, N, K; };

struct StaticOrder {
    int nM, nN, nwg, G, c;
    __host__ __device__ void init(int M, int N, int G_, int c_) { nM = M / BM; nN = N / BM; nwg = nM * nN; G = G_; c = c_; }
    __host__ __device__ bool next(int i, Unit& u) const {
        const long L = (long)i * G + c; if (L >= nwg) return false;
        int wgid = (int)L; { const int q = nwg / NXCD, r = nwg % NXCD, xcd = wgid % NXCD, off = wgid / NXCD; wgid = (xcd < r ? xcd * (q + 1) : r * (q + 1) + (xcd - r) * q) + off; }
        const int nig = WGM * nN, gid = wgid / nig, fm = gid * WGM, gsz = (nM - fm) < WGM ? (nM - fm) : WGM;
        u.pm = fm + ((wgid % nig) % gsz); u.pn = (wgid % nig) / gsz; return true;
    }
    __device__ __forceinline__ void a_ready(const Unit&) const {}
    __device__ __forceinline__ void done(const Unit&) const {}
};

__device__ __forceinline__ unsigned cvt_pk_bf16(float lo, float hi) { unsigned r; asm volatile("v_cvt_pk_bf16_f32 %0, %1, %2" : "=v"(r) : "v"(lo), "v"(hi)); return r; }
typedef float f32x2 __attribute__((ext_vector_type(2)));
__device__ __forceinline__ f32x2 gelu_pk(f32x2 v) {
    const f32x2 av = __builtin_elementwise_abs(v), d = av * 0.2316418882f + 1.0f;
    f32x2 t; t.x = __builtin_amdgcn_rcpf(d.x); t.y = __builtin_amdgcn_rcpf(d.y);
    f32x2 q = t * 0.5307027145f + (-0.7265760135f); q = q * t + 0.7107068705f; q = q * t + (-0.142248368f); q = q * t + 0.127414796f; q = q * t;
    const f32x2 s = (v * v) * (-0.72134752044f);
    f32x2 e; e.x = __builtin_amdgcn_exp2f(s.x); e.y = __builtin_amdgcn_exp2f(s.y);
    const f32x2 m = v * (q * e), r = v - m;
    f32x2 o; o.x = v.x < 0.f ? m.x : r.x; o.y = v.y < 0.f ? m.y : r.y; return o;
}

template <int ACT  > struct EpiBf16 {
    static constexpr bool PERM = true, AFTER_DRAIN = false, HEADMAP = false; static_assert(ACT == 0 || ACT == 1, "EpiBf16: ACT is 0 (none) or 1 (gelu_pk)");
    bf16_t* O; int ldc; const float* bias; int split_cols; size_t split_stride; float scale0;
    __device__ __forceinline__ void operator()(const f32x4 (&acc)[2][2][4][2], const Unit& u, int wr, int wc, int fr, int fq) const {
        const int row0 = u.pm * BM + wr * 64 + fr; int colt = u.pn * BM; bf16_t* base = O;
        float sc = 1.f; if (split_cols) { const int t = colt / split_cols; base += (size_t)t * split_stride; colt -= t * split_cols; if (t == 0) sc = scale0; }
        const int col0 = colt + wc * 32 + 8 * fq, bcol0 = u.pn * BM + wc * 32 + 8 * fq;
        f32x4 bv[2][2];
#pragma unroll
        for (int bj = 0; bj < 2; ++bj)
#pragma unroll
            for (int n = 0; n < 2; ++n) bv[bj][n] = bias ? *(const f32x4*)(bias + bcol0 + bj * HALF + 4 * n) : (f32x4){0.f, 0.f, 0.f, 0.f};
#pragma unroll
        for (int ai = 0; ai < 2; ++ai)
#pragma unroll
            for (int m = 0; m < 4; ++m) { bf16_t* rowp = base + (size_t)(row0 + ai * HALF + m * 16) * ldc + col0;
#pragma unroll
                for (int bj = 0; bj < 2; ++bj) { f32x4 v0 = acc[ai][bj][m][0] + bv[bj][0], v1 = acc[ai][bj][m][1] + bv[bj][1];
                    if (ACT == 1) { f32x2 a = gelu_pk((f32x2){v0[0], v0[1]}), b = gelu_pk((f32x2){v0[2], v0[3]}), c = gelu_pk((f32x2){v1[0], v1[1]}), d = gelu_pk((f32x2){v1[2], v1[3]});
                        v0 = (f32x4){a.x, a.y, b.x, b.y}; v1 = (f32x4){c.x, c.y, d.x, d.y}; }
                    v0 = v0 * sc; v1 = v1 * sc; u32x4 w; w.x = cvt_pk_bf16(v0[0], v0[1]); w.y = cvt_pk_bf16(v0[2], v0[3]); w.z = cvt_pk_bf16(v1[0], v1[1]); w.w = cvt_pk_bf16(v1[2], v1[3]);
                    *(u32x4*)(rowp + bj * HALF) = w; } }
    }
};
constexpr int X_TR = 16384, X_TALL = 16400, X_SEQ = 8192, X_KVROWS = 8256;
constexpr size_t X_Q_TO_RS = (size_t)(158 - 19) << 20;
__device__ __forceinline__ float xbl(unsigned u) { return __uint_as_float(u << 16); }
__device__ __forceinline__ float xbh(unsigned u) { return __uint_as_float(u & 0xffff0000u); }
template <bool BASE_BF16> struct EpiResB {
    static constexpr bool PERM = true, AFTER_DRAIN = false, HEADMAP = false;
    const void* base; bf16_t* H;
    __device__ __forceinline__ void operator()(const f32x4 (&acc)[2][2][4][2], const Unit& u, int wr, int wc, int fr, int fq) const {
        const int col0 = u.pn * BM + wc * 32 + 8 * fq;
        constexpr int MB = BASE_BF16 ? 4 : 2;
#pragma unroll
        for (int ai = 0; ai < 2; ++ai)
#pragma unroll
            for (int m0 = 0; m0 < 4; m0 += MB) {
                f32x4 b0[MB][2], b1[MB][2];
#pragma unroll
                for (int mm = 0; mm < MB; ++mm)
#pragma unroll
                    for (int bj = 0; bj < 2; ++bj) { const size_t ro = (size_t)(u.pm * BM + ai * HALF + wr * 64 + (m0 + mm) * 16 + fr) * 1024 + col0 + bj * HALF;
                        if (BASE_BF16) { const u32x4 raw = *(const u32x4*)((const bf16_t*)base + ro); b0[mm][bj] = (f32x4){xbl(raw.x), xbh(raw.x), xbl(raw.y), xbh(raw.y)}; b1[mm][bj] = (f32x4){xbl(raw.z), xbh(raw.z), xbl(raw.w), xbh(raw.w)}; }
                        else { b0[mm][bj] = __builtin_nontemporal_load((const f32x4*)((const float*)base + ro)); b1[mm][bj] = __builtin_nontemporal_load((const f32x4*)((const float*)base + ro + 4)); } }
#pragma unroll
                for (int mm = 0; mm < MB; ++mm)
#pragma unroll
                    for (int bj = 0; bj < 2; ++bj) { const size_t ro = (size_t)(u.pm * BM + ai * HALF + wr * 64 + (m0 + mm) * 16 + fr) * 1024 + col0 + bj * HALF;
                        const f32x4 v0 = acc[ai][bj][m0 + mm][0] + b0[mm][bj], v1 = acc[ai][bj][m0 + mm][1] + b1[mm][bj];
                        u32x4 w; w.x = cvt_pk_bf16(v0[0], v0[1]); w.y = cvt_pk_bf16(v0[2], v0[3]); w.z = cvt_pk_bf16(v1[0], v1[1]); w.w = cvt_pk_bf16(v1[2], v1[3]);
                        *(u32x4*)(H + ro) = w; }
            }
    }
};
struct EpiKV {
    static constexpr bool PERM = true, AFTER_DRAIN = false, HEADMAP = false;
    bf16_t* Kb; bf16_t* Vb;
    __device__ __forceinline__ void operator()(const f32x4 (&acc)[2][2][4][2], const Unit& u, int wr, int wc, int fr, int fq) const {
        const int row0 = u.pm * BM + wr * 64 + fr; int colt = u.pn * BM; bf16_t* base = Kb;
        if (colt >= 1024) { base = Vb; colt -= 1024; }
        const int col0 = colt + wc * 32 + 8 * fq;
#pragma unroll
        for (int ai = 0; ai < 2; ++ai)
#pragma unroll
            for (int m = 0; m < 4; ++m) {
                const int r = row0 + ai * HALF + m * 16;
                if (r >= X_TALL) continue;
                size_t d0, d1; bool two = false;
                if (r < X_TR) { d0 = (size_t)(r >> 13) * X_KVROWS + 64 + (r & (X_SEQ - 1)); d1 = d0; }
                else { d0 = (size_t)(r - X_TR); d1 = d0 + X_KVROWS; two = true; }
#pragma unroll
                for (int bj = 0; bj < 2; ++bj) { const f32x4 v0 = acc[ai][bj][m][0], v1 = acc[ai][bj][m][1];
                    u32x4 w; w.x = cvt_pk_bf16(v0[0], v0[1]); w.y = cvt_pk_bf16(v0[2], v0[3]); w.z = cvt_pk_bf16(v1[0], v1[1]); w.w = cvt_pk_bf16(v1[2], v1[3]);
                    *(u32x4*)(base + d0 * 1024 + col0 + bj * HALF) = w;
                    if (two) *(u32x4*)(base + d1 * 1024 + col0 + bj * HALF) = w; }
            }
    }
};

struct EpiKVN {
    static constexpr bool PERM = true, AFTER_DRAIN = false, HEADMAP = true;
    bf16_t* Kb; bf16_t* Vb; const float* gk; const float* rs;
    __device__ __forceinline__ void operator()(const f32x4 (&acc)[2][2][4][2], const Unit& u, int wr, int wc, int fr, int fq) const {
        const int row0 = u.pm * BM + wr * 64 + fr; int colt = u.pn * BM; bf16_t* base = Kb; const bool isK = colt < 1024;
        if (!isK) { base = Vb; colt -= 1024; }
        const int col0 = colt + wc * 64 + 8 * fq;
        f32x4 gv[2][2];
#pragma unroll
        for (int bj = 0; bj < 2; ++bj)
#pragma unroll
            for (int n = 0; n < 2; ++n) gv[bj][n] = isK ? *(const f32x4*)(gk + 32 * bj + 8 * fq + 4 * n) : (f32x4){1.f, 1.f, 1.f, 1.f};
        float rsa[2][4];
#pragma unroll
        for (int ai = 0; ai < 2; ++ai)
#pragma unroll
            for (int m = 0; m < 4; ++m) rsa[ai][m] = rs[row0 + ai * HALF + m * 16];
#pragma unroll
        for (int ai = 0; ai < 2; ++ai)
#pragma unroll
            for (int m = 0; m < 4; ++m) {
                const int r = row0 + ai * HALF + m * 16;
                float rstd = rsa[ai][m];
                if (isK) { float ss = 0.f;
#pragma unroll
                    for (int bj = 0; bj < 2; ++bj)
#pragma unroll
                        for (int n = 0; n < 2; ++n) { const f32x4 v = acc[ai][bj][m][n]; ss += (v[0] * v[0] + v[1] * v[1]) + (v[2] * v[2] + v[3] * v[3]); }
                    ss += __shfl_xor(ss, 16); ss += __shfl_xor(ss, 32);
                    rstd = rstd * rsqrtf(ss * (rstd * rstd * (1.f / 64.f)) + 1e-6f); }
                if (r >= X_TALL) continue;
                size_t d0, d1; bool two = false;
                if (r < X_TR) { d0 = (size_t)(r >> 13) * X_KVROWS + 64 + (r & (X_SEQ - 1)); d1 = d0; }
                else { d0 = (size_t)(r - X_TR); d1 = d0 + X_KVROWS; two = true; }
#pragma unroll
                for (int bj = 0; bj < 2; ++bj) { const f32x4 v0 = acc[ai][bj][m][0] * rstd * gv[bj][0], v1 = acc[ai][bj][m][1] * rstd * gv[bj][1];
                    u32x4 w; w.x = cvt_pk_bf16(v0[0], v0[1]); w.y = cvt_pk_bf16(v0[2], v0[3]); w.z = cvt_pk_bf16(v1[0], v1[1]); w.w = cvt_pk_bf16(v1[2], v1[3]);
                    *(u32x4*)(base + d0 * 1024 + col0 + bj * 32) = w;
                    if (two) *(u32x4*)(base + d1 * 1024 + col0 + bj * 32) = w; }
            }
    }
};
struct EpiQN {
    static constexpr bool PERM = true, AFTER_DRAIN = false, HEADMAP = true;
    bf16_t* Qb; const float* gq; float scale;
    __device__ __forceinline__ void operator()(const f32x4 (&acc)[2][2][4][2], const Unit& u, int wr, int wc, int fr, int fq) const {
        const int row0 = u.pm * BM + wr * 64 + fr; const int col0 = u.pn * BM + wc * 64 + 8 * fq; const float* rs = (const float*)((const char*)Qb - X_Q_TO_RS);
        f32x4 gv[2][2];
#pragma unroll
        for (int bj = 0; bj < 2; ++bj)
#pragma unroll
            for (int n = 0; n < 2; ++n) gv[bj][n] = *(const f32x4*)(gq + 32 * bj + 8 * fq + 4 * n) * scale;
        float rsa[2][4];
#pragma unroll
        for (int ai = 0; ai < 2; ++ai)
#pragma unroll
            for (int m = 0; m < 4; ++m) rsa[ai][m] = rs[row0 + ai * HALF + m * 16];
#pragma unroll
        for (int ai = 0; ai < 2; ++ai)
#pragma unroll
            for (int m = 0; m < 4; ++m) {
                const int r = row0 + ai * HALF + m * 16;
                float ss = 0.f;
#pragma unroll
                for (int bj = 0; bj < 2; ++bj)
#pragma unroll
                    for (int n = 0; n < 2; ++n) { const f32x4 v = acc[ai][bj][m][n]; ss += (v[0] * v[0] + v[1] * v[1]) + (v[2] * v[2] + v[3] * v[3]); }
                ss += __shfl_xor(ss, 16); ss += __shfl_xor(ss, 32);
                const float rsv = rsa[ai][m]; const float rstd = rsv * rsqrtf(ss * (rsv * rsv * (1.f / 64.f)) + 1e-6f);
#pragma unroll
                for (int bj = 0; bj < 2; ++bj) { const f32x4 v0 = acc[ai][bj][m][0] * rstd * gv[bj][0], v1 = acc[ai][bj][m][1] * rstd * gv[bj][1];
                    u32x4 w; w.x = cvt_pk_bf16(v0[0], v0[1]); w.y = cvt_pk_bf16(v0[2], v0[3]); w.z = cvt_pk_bf16(v1[0], v1[1]); w.w = cvt_pk_bf16(v1[2], v1[3]);
                    *(u32x4*)(Qb + (size_t)r * 1024 + col0 + bj * 32) = w; }
            }
    }
};

struct Unit2 { int mt, nv, aux, roff, bkt; };
struct Gemm2 { const char* A; int K, ldb; };
constexpr int MOE_NB = 24, MOE_CAP = 16400;
__device__ __forceinline__ void moe_pair(int pi, int& lo, int& hi) { lo = pi < 3 ? 0 : (pi < 5 ? 1 : 2); hi = pi < 3 ? pi + 1 : (pi < 5 ? pi - 1 : 3); }
template <int WHICH> struct MoeSched {
    const PG8_LAS int* tbl;
    const int* list; const char* W; int G, c;
    unsigned* rdy;
    __device__ __forceinline__ bool next(int i, Unit2& u) const {
        const int mtot = __builtin_amdgcn_readfirstlane(tbl[60]);
        int id;
        if (WHICH == 1) id = i * G + c;
        else { int nl = 4 * mtot - G; nl = nl > 0 ? nl : 0; const int nf = G - nl; if (c < nl) return false; id = (c - nl) + i * nf; }
        const int mt = id >> 2;
        if (mt >= mtot) return false;
        const int pk = __builtin_amdgcn_readfirstlane(tbl[64 + mt]), b = pk >> 16, t0 = pk & 0xffff;
        u.mt = __builtin_amdgcn_readfirstlane(mt); u.aux = __builtin_amdgcn_readfirstlane(id & 3); u.bkt = b; const int rem = __builtin_amdgcn_readfirstlane(tbl[32 + b]) - t0 * 256; u.nv = rem < 256 ? rem : 256; u.roff = b * MOE_CAP + t0 * 256;
        return true;
    }
    __device__ __forceinline__ void a_ready(const Unit2& u) const {
        if (WHICH == 2) {
            if (threadIdx.x < 64) {
                unsigned spins = 0;
                while ((unsigned)__builtin_amdgcn_readfirstlane(__hip_atomic_load(rdy + 64 * u.mt, __ATOMIC_RELAXED, __HIP_MEMORY_SCOPE_AGENT)) < 32u) { __builtin_amdgcn_s_sleep(2); if (++spins > (1u << 22)) break; }
                __builtin_amdgcn_fence(__ATOMIC_ACQUIRE, "agent");
                asm volatile("s_waitcnt vmcnt(0)" ::: "memory");
            }
            asm volatile("" ::: "memory"); __builtin_amdgcn_s_barrier(); asm volatile("" ::: "memory");
        }
    }
    __device__ __forceinline__ void done(const Unit2& u) const {
        if (WHICH == 1) {
            asm volatile("s_waitcnt vmcnt(0)" ::: "memory");
            if ((threadIdx.x & 63) == 0) __hip_atomic_fetch_add(rdy + 64 * u.mt, 1u, __ATOMIC_RELAXED, __HIP_MEMORY_SCOPE_AGENT);
        }
    }
    __device__ __forceinline__ const char* b_base(const Unit2& u) const {
        const int grp = u.bkt / 6, pi = u.bkt - grp * 6; int lo, hi; moe_pair(pi, lo, hi);
        if (WHICH == 1) { const int sw = (pi == 2) ? 1 : 0; const int e = grp * 4 + (((u.aux >> 1) ^ sw) ? hi : lo); return W + (size_t)(e * 2 + (u.aux & 1)) * (256 * 1024 * 2); }
        const int blk = pi == 0 ? 0 : (pi == 1 ? 4 : (pi == 2 ? 3 : (pi == 3 ? 1 : (pi == 4 ? 6 : 2))));
        return W + (size_t)u.aux * ((size_t)256 * 8192 * 2) + (size_t)(grp * 8 + blk) * 512;
    }
    __device__ __forceinline__ void a_offs(const Unit2& u, int tid, unsigned (&v0)[2], unsigned (&v1)[2]) const {
#pragma unroll
        for (int i = 0; i < 2; ++i) { int R, C; stage_rc(tid * 16 + i * 8192, R, C);
            if (WHICH == 1) { int r0 = R, r1 = 128 + R; r0 = r0 < u.nv ? r0 : u.nv - 1; r1 = r1 < u.nv ? r1 : u.nv - 1;
                v0[i] = (unsigned)(list[u.roff + r0] * 1024 + C) * 2u; v1[i] = (unsigned)(list[u.roff + r1] * 1024 + C) * 2u; }
            else { v0[i] = (unsigned)((u.mt * 256 + R) * 512 + C) * 2u; v1[i] = (unsigned)((u.mt * 256 + 128 + R) * 512 + C) * 2u; } }
    }
};
struct EpiMoe1 {
    static constexpr bool PERM = true, AFTER_DRAIN = false, HEADMAP = false;
    bf16_t* ACT; const float* LP;
    __device__ __forceinline__ void operator()(const f32x4 (&acc)[2][2][4][2], const Unit2& u, int wr, int wc, int fr, int fq) const {
        const int slot = u.aux >> 1, col0 = slot * 256 + (u.aux & 1) * 128 + wc * 32 + 8 * fq; const int sw = (u.bkt % 6 == 2) ? 1 : 0;
        float pr[2][4], rsv[2][4];
#pragma unroll
        for (int ai = 0; ai < 2; ++ai)
#pragma unroll
            for (int m = 0; m < 4; ++m) { const int rl = ai * HALF + wr * 64 + m * 16 + fr; const int rc = rl < u.nv ? rl : u.nv - 1;
                const float* lp = LP + (size_t)(u.roff + rc) * 4; pr[ai][m] = lp[slot ^ sw]; rsv[ai][m] = lp[2]; }
        const int nai = u.nv > 128 ? 2 : 1;
#pragma unroll
        for (int ai = 0; ai < 2; ++ai) if (ai < nai)
#pragma unroll
            for (int m = 0; m < 4; ++m) {
                const int rl = ai * HALF + wr * 64 + m * 16 + fr;
                const float p = pr[ai][m], rs1 = rsv[ai][m];
                const f32x4 g0 = acc[ai][0][m][0] * rs1, g1 = acc[ai][0][m][1] * rs1, u0 = acc[ai][1][m][0], u1 = acc[ai][1][m][1];
                f32x4 a0, a1;
#pragma unroll
                for (int i = 0; i < 4; ++i) { a0[i] = g0[i] * __builtin_amdgcn_rcpf(1.f + __expf(-g0[i])) * u0[i] * p; a1[i] = g1[i] * __builtin_amdgcn_rcpf(1.f + __expf(-g1[i])) * u1[i] * p; }
                u32x4 w; w.x = cvt_pk_bf16(a0[0], a0[1]); w.y = cvt_pk_bf16(a0[2], a0[3]); w.z = cvt_pk_bf16(a1[0], a1[1]); w.w = cvt_pk_bf16(a1[2], a1[3]);
                { const bf16_t* dst = ACT + (size_t)(u.mt * 256 + rl) * 512 + col0; asm volatile("global_store_dwordx4 %0, %1, off sc1\n\ts_nop 1" :: "v"(dst), "v"(w) : "memory"); }
            }
    }
};
template <bool FINAL> struct EpiMoe2R {
    static constexpr bool PERM = true, AFTER_DRAIN = false, HEADMAP = false;
    const bf16_t* Hin; void* dst; const int* list;
    __device__ __forceinline__ void operator()(const f32x4 (&acc)[2][2][4][2], const Unit2& u, int wr, int wc, int fr, int fq) const {
        const int col0 = u.aux * BM + wc * 32 + 8 * fq;
        int tok[2][4];
#pragma unroll
        for (int ai = 0; ai < 2; ++ai)
#pragma unroll
            for (int m = 0; m < 4; ++m) { const int rl = ai * HALF + wr * 64 + m * 16 + fr; tok[ai][m] = list[u.roff + (rl < u.nv ? rl : 0)]; }
#pragma unroll
        for (int ai = 0; ai < 2; ++ai) {
            u32x4 raw[4][2];
#pragma unroll
            for (int m = 0; m < 4; ++m)
#pragma unroll
                for (int bj = 0; bj < 2; ++bj) raw[m][bj] = *(const u32x4*)(Hin + (size_t)tok[ai][m] * 1024 + col0 + bj * HALF);
#pragma unroll
            for (int m = 0; m < 4; ++m) {
                const int rl = ai * HALF + wr * 64 + m * 16 + fr;
                if (rl < u.nv) {
                    const size_t ro = (size_t)tok[ai][m] * 1024 + col0;
#pragma unroll
                    for (int bj = 0; bj < 2; ++bj) { const u32x4 rw = raw[m][bj];
                        const f32x4 v0 = acc[ai][bj][m][0] + (f32x4){xbl(rw.x), xbh(rw.x), xbl(rw.y), xbh(rw.y)}, v1 = acc[ai][bj][m][1] + (f32x4){xbl(rw.z), xbh(rw.z), xbl(rw.w), xbh(rw.w)};
                        if (FINAL) { __builtin_nontemporal_store(v0, (f32x4*)((float*)dst + ro + bj * HALF)); __builtin_nontemporal_store(v1, (f32x4*)((float*)dst + ro + bj * HALF + 4)); }
                        else { u32x4 w; w.x = cvt_pk_bf16(v0[0], v0[1]); w.y = cvt_pk_bf16(v0[2], v0[3]); w.z = cvt_pk_bf16(v1[0], v1[1]); w.w = cvt_pk_bf16(v1[2], v1[3]);
                            *(u32x4*)((bf16_t*)dst + ro + bj * HALF) = w; } }
                }
            }
        }
    }
};
template <class Epi, class Sched, bool ALIGN_EPI = false, bool SP2 = false>
__device__ __forceinline__ void gemm_phase(PG8_LAS unsigned char* lds, const Gemm g, const Sched& S, const Epi& E) {
    const int tid = threadIdx.x, wid = __builtin_amdgcn_readfirstlane(tid >> 6), lane = tid & 63, wr = wid >> 2, wc = wid & 3, fr = lane & 15, fq = lane >> 4;
    const int K = g.K, nt = K / BK;
    unsigned voffA[2], voffB[2];
#pragma unroll
    for (int i = 0; i < 2; ++i) { int R, C; stage_rc(tid * 16 + i * 8192, R, C); const int Rb = Epi::HEADMAP ? (2 * (R & ~31) + perm32(R & 31)) : (Epi::PERM ? ((R & ~31) + perm32(R & 31)) : R);
        voffA[i] = (unsigned)(R * K + C) * 2u; voffB[i] = (unsigned)(Rb * K + C) * 2u; }
    const size_t kstep = (size_t)(BK * 2);
    const size_t hstep = (size_t)HALF * K * 2;
    const size_t tstep = 2 * hstep;
    const size_t hstepB = Epi::HEADMAP ? (size_t)32 * K * 2 : hstep;
    const unsigned ldsw = (unsigned)wid * 1024u;
    const int aoff = lds_byte(wr * 64 + fr, fq * 8), boff = lds_byte(wc * 32 + fr, fq * 8);
#define PG8_SA(b, h) (((b) * 2 + (h)) * HTB)
#define PG8_SB(b, h) ((4 + (b) * 2 + (h)) * HTB)
#define PG8_STAGE(bufoff, gbase, voff) do { _Pragma("unroll") for (int _i = 0; _i < 2; ++_i) \
        __builtin_amdgcn_global_load_lds((const unsigned*)((const char*)(gbase) + (voff)[_i]), (PG8_LAS unsigned*)(lds + (bufoff) + ldsw + _i * 8192), 16, 0, 0); } while (0)
#define PG8_LDA(dst, b, h) do { _Pragma("unroll") for (int m = 0; m < 4; ++m) _Pragma("unroll") for (int k = 0; k < 2; ++k) dst[m][k] = *(const PG8_LAS bf16x8*)(lds + PG8_SA(b, h) + aoff + m * 2048 + k * 1024); } while (0)
#define PG8_LDB(dst, b, h) do { _Pragma("unroll") for (int n = 0; n < 2; ++n) _Pragma("unroll") for (int k = 0; k < 2; ++k) dst[n][k] = *(const PG8_LAS bf16x8*)(lds + PG8_SB(b, h) + boff + n * 2048 + k * 1024); } while (0)
#define PG8_MMA(ai, bj, At, Bt) do { __builtin_amdgcn_s_setprio(1); _Pragma("unroll") for (int m = 0; m < 4; ++m) _Pragma("unroll") for (int n = 0; n < 2; ++n) _Pragma("unroll") for (int k = 0; k < 2; ++k) \
        acc[ai][bj][m][n] = __builtin_amdgcn_mfma_f32_16x16x32_bf16(Bt[n][k], At[m][k], acc[ai][bj][m][n], 0, 0, 0); __builtin_amdgcn_s_setprio(0); } while (0)
#define PG8_WAIT_V(n) asm volatile("s_waitcnt vmcnt(" #n ")" ::: "memory")
#define PG8_WAIT_L(n) asm volatile("s_waitcnt lgkmcnt(" #n ")" ::: "memory")
#define PG8_BAR __builtin_amdgcn_s_barrier()
#define PG8_SCHED __builtin_amdgcn_sched_barrier(0)
    Unit cur, nxt; int ui = 0;
    if (!S.next(0, cur)) return;
    f32x4 acc[2][2][4][2];
#pragma unroll
    for (int a = 0; a < 2; ++a)
#pragma unroll
        for (int b = 0; b < 2; ++b)
#pragma unroll
            for (int m = 0; m < 4; ++m)
#pragma unroll
                for (int n = 0; n < 2; ++n) acc[a][b][m][n] = (f32x4){0.f, 0.f, 0.f, 0.f};
    bf16x8 At[4][2], B0[2][2], B1[2][2];
    const char* cA = (const char*)g.A + (size_t)cur.pm * tstep; const char* cB = (const char*)g.Bt + (size_t)cur.pn * tstep;
    S.a_ready(cur);
    if constexpr (SP2) {
        PG8_STAGE(PG8_SB(0, 0), cB, voffB); PG8_STAGE(PG8_SB(0, 1), cB + hstepB, voffB); PG8_STAGE(PG8_SA(0, 0), cA, voffA); PG8_STAGE(PG8_SA(0, 1), cA + hstep, voffA);
        if (wr == 1) PG8_BAR;
        PG8_WAIT_V(2); PG8_BAR;
        PG8_STAGE(PG8_SB(1, 0), cB + kstep, voffB); PG8_STAGE(PG8_SA(1, 0), cA + kstep, voffA); PG8_STAGE(PG8_SB(1, 1), cB + hstepB + kstep, voffB);
        PG8_WAIT_V(6); PG8_BAR;
    } else {
        PG8_STAGE(PG8_SB(0, 0), cB, voffB); PG8_STAGE(PG8_SA(0, 0), cA, voffA); PG8_STAGE(PG8_SB(0, 1), cB + hstepB, voffB); PG8_STAGE(PG8_SA(0, 1), cA + hstep, voffA);
        if (wr == 1) PG8_BAR;
        PG8_WAIT_V(4); PG8_BAR;
        PG8_STAGE(PG8_SB(1, 0), cB + kstep, voffB); PG8_STAGE(PG8_SA(1, 0), cA + kstep, voffA); PG8_STAGE(PG8_SB(1, 1), cB + hstepB + kstep, voffB);
        PG8_WAIT_V(6); PG8_BAR;
    }
    for (;;) {
        const bool has_next = S.next(ui + 1, nxt);
        const char* nA = has_next ? (const char*)g.A + (size_t)nxt.pm * tstep : cA; const char* nB = has_next ? (const char*)g.Bt + (size_t)nxt.pn * tstep : cB;
        for (int t = 0; t < nt; t += 2) {
            const bool last = (t == nt - 2);
            const char* a1 = cA + (size_t)(t + 1) * kstep;
            const char* a2 = last ? nA : cA + (size_t)(t + 2) * kstep; const char* b2 = last ? nB : cB + (size_t)(t + 2) * kstep;
            const char* a3 = a2 + kstep; const char* b3 = b2 + kstep;
            if (last && has_next) S.a_ready(nxt);
            if constexpr (SP2) {
            PG8_LDB(B0, 0, 0); PG8_LDB(B1, 0, 1); PG8_SCHED; PG8_LDA(At, 0, 0); PG8_STAGE(PG8_SA(1, 1), a1 + hstep, voffA);
            PG8_WAIT_V(8); PG8_WAIT_L(0); PG8_BAR; PG8_MMA(0, 0, At, B0); PG8_MMA(0, 1, At, B1); PG8_BAR; PG8_SCHED;
            PG8_LDA(At, 0, 1); PG8_STAGE(PG8_SB(0, 0), b2, voffB); PG8_STAGE(PG8_SB(0, 1), b2 + hstepB, voffB); PG8_STAGE(PG8_SA(0, 0), a2, voffA);
            PG8_WAIT_V(8); PG8_WAIT_L(0); PG8_BAR; PG8_MMA(1, 0, At, B0); PG8_MMA(1, 1, At, B1); PG8_BAR; PG8_SCHED;
            PG8_LDB(B0, 1, 0); PG8_LDB(B1, 1, 1); PG8_SCHED; PG8_LDA(At, 1, 0); PG8_STAGE(PG8_SA(0, 1), a2 + hstep, voffA);
            PG8_WAIT_V(8); PG8_WAIT_L(0); PG8_BAR; PG8_MMA(0, 0, At, B0); PG8_MMA(0, 1, At, B1); PG8_BAR; PG8_SCHED;
            PG8_LDA(At, 1, 1); PG8_STAGE(PG8_SB(1, 0), b3, voffB); PG8_STAGE(PG8_SB(1, 1), b3 + hstepB, voffB); PG8_STAGE(PG8_SA(1, 0), a3, voffA);
            PG8_WAIT_V(8); PG8_WAIT_L(0); PG8_BAR; PG8_MMA(1, 0, At, B0); PG8_MMA(1, 1, At, B1); PG8_BAR; PG8_SCHED;
            } else {
            PG8_LDB(B0, 0, 0); PG8_SCHED; PG8_LDA(At, 0, 0); PG8_STAGE(PG8_SA(1, 1), a1 + hstep, voffA);
            PG8_WAIT_L(8); PG8_BAR; PG8_WAIT_L(0); PG8_MMA(0, 0, At, B0); PG8_BAR; PG8_SCHED;
            PG8_LDB(B1, 0, 1); PG8_STAGE(PG8_SB(0, 0), b2, voffB);
            PG8_BAR; PG8_WAIT_L(0); PG8_MMA(0, 1, At, B1); PG8_BAR;
            PG8_LDA(At, 0, 1); PG8_STAGE(PG8_SA(0, 0), a2, voffA);
            PG8_BAR; PG8_WAIT_L(0); PG8_MMA(1, 0, At, B0); PG8_BAR; PG8_SCHED;
            PG8_STAGE(PG8_SB(0, 1), b2 + hstepB, voffB);
            PG8_WAIT_V(6); PG8_BAR; PG8_MMA(1, 1, At, B1); PG8_BAR;
            PG8_LDB(B0, 1, 0); PG8_SCHED; PG8_LDA(At, 1, 0); PG8_STAGE(PG8_SA(0, 1), a2 + hstep, voffA);
            PG8_WAIT_L(8); PG8_BAR; PG8_WAIT_L(0); PG8_MMA(0, 0, At, B0); PG8_BAR; PG8_SCHED;
            PG8_LDB(B1, 1, 1); PG8_STAGE(PG8_SB(1, 0), b3, voffB);
            PG8_BAR; PG8_WAIT_L(0); PG8_MMA(0, 1, At, B1); PG8_BAR;
            PG8_LDA(At, 1, 1); PG8_STAGE(PG8_SA(1, 0), a3, voffA);
            PG8_BAR; PG8_WAIT_L(0); PG8_MMA(1, 0, At, B0); PG8_BAR; PG8_SCHED;
            PG8_STAGE(PG8_SB(1, 1), b3 + hstepB, voffB);
            PG8_WAIT_V(6); PG8_BAR; PG8_MMA(1, 1, At, B1); PG8_BAR;
            }
        }
        if constexpr (ALIGN_EPI) { if (wr == 0) PG8_BAR; }
        if constexpr (!Epi::AFTER_DRAIN) { E(acc, cur, wr, wc, fr, fq); S.done(cur); }
        if (!has_next) break;
#pragma unroll
        for (int a = 0; a < 2; ++a)
#pragma unroll
            for (int b = 0; b < 2; ++b)
#pragma unroll
                for (int m = 0; m < 4; ++m)
#pragma unroll
                    for (int n = 0; n < 2; ++n) acc[a][b][m][n] = (f32x4){0.f, 0.f, 0.f, 0.f};
        cur = nxt; cA = nA; cB = nB; ++ui;
        if constexpr (ALIGN_EPI) { if (wr == 1) PG8_BAR; }
    }
    PG8_WAIT_V(0);
    if constexpr (!ALIGN_EPI) { if (wr == 0) PG8_BAR; }
    PG8_BAR;
    if constexpr (Epi::AFTER_DRAIN) { E.fused(acc, cur, wr, wc, fr, fq, lds, wid, lane); S.done(cur); }
#undef PG8_SA
#undef PG8_SB
#undef PG8_STAGE
#undef PG8_LDA
#undef PG8_LDB
#undef PG8_MMA
#undef PG8_WAIT_V
#undef PG8_WAIT_L
#undef PG8_BAR
#undef PG8_SCHED
}
}
namespace pg8 {
template <class Epi, class Sched>
__device__ __forceinline__ void gemm_phase2(PG8_LAS unsigned char* lds, PG8_LAS unsigned* offs  , const Gemm2 g, const Sched& S, const Epi& E) {
    const int tid = threadIdx.x, wid = __builtin_amdgcn_readfirstlane(tid >> 6), lane = tid & 63, wr = wid >> 2, wc = wid & 3, fr = lane & 15, fq = lane >> 4;
    const int K = g.K, nt = K / BK;
    unsigned voffB[2];
#pragma unroll
    for (int i = 0; i < 2; ++i) { int R, C; stage_rc(tid * 16 + i * 8192, R, C); const int Rb = Epi::PERM ? ((R & ~31) + perm32(R & 31)) : R;
        voffB[i] = (unsigned)(Rb * g.ldb + C) * 2u; }
    const size_t kstep = (size_t)(BK * 2);
    const size_t hstepB = (size_t)HALF * g.ldb * 2;
    const unsigned ldsw = (unsigned)wid * 1024u;
    const int aoff = lds_byte(wr * 64 + fr, fq * 8), boff = lds_byte(wc * 32 + fr, fq * 8);
#define PG8_SA(b, h) (((b) * 2 + (h)) * HTB)
#define PG8_SB(b, h) ((4 + (b) * 2 + (h)) * HTB)
#define PG8_STAGE(bufoff, gbase, voff) do { _Pragma("unroll") for (int _i = 0; _i < 2; ++_i) \
        __builtin_amdgcn_global_load_lds((const unsigned*)((const char*)(gbase) + (voff)[_i]), (PG8_LAS unsigned*)(lds + (bufoff) + ldsw + _i * 8192), 16, 0, 0); } while (0)
#define PG8_LDA(dst, b, h) do { _Pragma("unroll") for (int m = 0; m < 4; ++m) _Pragma("unroll") for (int k = 0; k < 2; ++k) dst[m][k] = *(const PG8_LAS bf16x8*)(lds + PG8_SA(b, h) + aoff + m * 2048 + k * 1024); } while (0)
#define PG8_LDB(dst, b, h) do { _Pragma("unroll") for (int n = 0; n < 2; ++n) _Pragma("unroll") for (int k = 0; k < 2; ++k) dst[n][k] = *(const PG8_LAS bf16x8*)(lds + PG8_SB(b, h) + boff + n * 2048 + k * 1024); } while (0)
#define PG8_MMA(ai, bj, At, Bt) do { __builtin_amdgcn_s_setprio(1); _Pragma("unroll") for (int m = 0; m < 4; ++m) _Pragma("unroll") for (int n = 0; n < 2; ++n) _Pragma("unroll") for (int k = 0; k < 2; ++k) \
        acc[ai][bj][m][n] = __builtin_amdgcn_mfma_f32_16x16x32_bf16(Bt[n][k], At[m][k], acc[ai][bj][m][n], 0, 0, 0); __builtin_amdgcn_s_setprio(0); } while (0)
#define PG8_WAIT_V(n) asm volatile("s_waitcnt vmcnt(" #n ")" ::: "memory")
#define PG8_WAIT_L(n) asm volatile("s_waitcnt lgkmcnt(" #n ")" ::: "memory")
#define PG8_BAR __builtin_amdgcn_s_barrier()
#define PG8_SCHED __builtin_amdgcn_sched_barrier(0)
#define PG8_KLOOP(FULL) do { \
        for (int t = 0; t < nt; t += 2) { \
            const bool last = (t == nt - 2); \
            if (last && has_next) S.a_ready(nxt); \
            const char* a1 = cA + (size_t)(t + 1) * kstep; \
            const char* a2 = last ? cA : cA + (size_t)(t + 2) * kstep; const char* a3 = a2 + kstep; \
            const char* b2 = last ? nB : cB + (size_t)(t + 2) * kstep; const char* b3 = b2 + kstep; \
            const int so_x = last ? so_nxt : so_cur; \
            PG8_LDB(B0, 0, 0); PG8_LDB(B1, 0, 1); PG8_SCHED; PG8_LDA(At, 0, 0); PG8_STAGE_A(PG8_SA(1, 1), a1, 1, so_cur); \
            PG8_WAIT_V(8); PG8_WAIT_L(0); PG8_BAR; PG8_MMA(0, 0, At, B0); PG8_MMA(0, 1, At, B1); PG8_BAR; PG8_SCHED; \
            if (FULL) { PG8_LDA(At, 0, 1); } PG8_STAGE(PG8_SB(0, 0), b2, voffB); PG8_STAGE(PG8_SB(0, 1), b2 + hstepB, voffB); PG8_STAGE_A(PG8_SA(0, 0), a2, 0, so_x); \
            PG8_WAIT_V(8); PG8_WAIT_L(0); PG8_BAR; if (FULL) { PG8_MMA(1, 0, At, B0); PG8_MMA(1, 1, At, B1); } PG8_BAR; PG8_SCHED; \
            PG8_LDB(B0, 1, 0); PG8_LDB(B1, 1, 1); PG8_SCHED; PG8_LDA(At, 1, 0); PG8_STAGE_A(PG8_SA(0, 1), a2, 1, so_x); \
            PG8_WAIT_V(8); PG8_WAIT_L(0); PG8_BAR; PG8_MMA(0, 0, At, B0); PG8_MMA(0, 1, At, B1); PG8_BAR; PG8_SCHED; \
            if (FULL) { PG8_LDA(At, 1, 1); } PG8_STAGE(PG8_SB(1, 0), b3, voffB); PG8_STAGE(PG8_SB(1, 1), b3 + hstepB, voffB); PG8_STAGE_A(PG8_SA(1, 0), a3, 0, so_x); \
            PG8_WAIT_V(8); PG8_WAIT_L(0); PG8_BAR; if (FULL) { PG8_MMA(1, 0, At, B0); PG8_MMA(1, 1, At, B1); } PG8_BAR; PG8_SCHED; \
        } \
    } while (0)
    Unit2 cur, nxt; int ui = 0;
    if (!S.next(0, cur)) return;
    S.a_ready(cur);
    f32x4 acc[2][2][4][2];
#pragma unroll
    for (int a = 0; a < 2; ++a)
#pragma unroll
        for (int b = 0; b < 2; ++b)
#pragma unroll
            for (int m = 0; m < 4; ++m)
#pragma unroll
                for (int n = 0; n < 2; ++n) acc[a][b][m][n] = (f32x4){0.f, 0.f, 0.f, 0.f};
    bf16x8 At[4][2], B0[2][2], B1[2][2];
    PG8_LAS unsigned* myo = offs + 4 * tid;
    { unsigned v0[2], v1[2]; S.a_offs(cur, tid, v0, v1); myo[0] = v0[0]; myo[1] = v0[1]; myo[2] = v1[0]; myo[3] = v1[1]; }
    int so_cur = 0;
    const char* cA = g.A; const char* cB = S.b_base(cur);
#define PG8_STAGE_A(bufoff, gbase, h, so) do { const unsigned _o0 = myo[(so) + 2 * (h)], _o1 = myo[(so) + 2 * (h) + 1]; \
        __builtin_amdgcn_global_load_lds((const unsigned*)((const char*)(gbase) + _o0), (PG8_LAS unsigned*)(lds + (bufoff) + ldsw), 16, 0, 0); \
        __builtin_amdgcn_global_load_lds((const unsigned*)((const char*)(gbase) + _o1), (PG8_LAS unsigned*)(lds + (bufoff) + ldsw + 8192), 16, 0, 0); } while (0)
    PG8_STAGE(PG8_SB(0, 0), cB, voffB); PG8_STAGE(PG8_SB(0, 1), cB + hstepB, voffB); PG8_STAGE_A(PG8_SA(0, 0), cA, 0, 0); PG8_STAGE_A(PG8_SA(0, 1), cA, 1, 0);
    if (wr == 1) PG8_BAR;
    PG8_WAIT_V(2); PG8_BAR;
    PG8_STAGE(PG8_SB(1, 0), cB + kstep, voffB); PG8_STAGE_A(PG8_SA(1, 0), cA + kstep, 0, 0); PG8_STAGE(PG8_SB(1, 1), cB + hstepB + kstep, voffB);
    PG8_WAIT_V(6); PG8_BAR;
    for (;;) {
        const bool has_next = S.next(ui + 1, nxt);
        if (!has_next) nxt = cur;
        const char* nB = has_next ? S.b_base(nxt) : cB;
        const int so_nxt = has_next ? (so_cur ^ 2048) : so_cur;
        if (has_next) { unsigned n0[2], n1[2]; S.a_offs(nxt, tid, n0, n1); myo[so_nxt] = n0[0]; myo[so_nxt + 1] = n0[1]; myo[so_nxt + 2] = n1[0]; myo[so_nxt + 3] = n1[1]; }
        if (cur.nv > 128) PG8_KLOOP(1); else PG8_KLOOP(0);
        if (wr == 0) PG8_BAR;
        E(acc, cur, wr, wc, fr, fq);
        S.done(cur);
        if (!has_next) break;
#pragma unroll
        for (int a = 0; a < 2; ++a)
#pragma unroll
            for (int b = 0; b < 2; ++b)
#pragma unroll
                for (int m = 0; m < 4; ++m)
#pragma unroll
                    for (int n = 0; n < 2; ++n) acc[a][b][m][n] = (f32x4){0.f, 0.f, 0.f, 0.f};
        cur = nxt; cB = nB; ++ui; so_cur = so_nxt;
        if (wr == 1) PG8_BAR;
    }
    PG8_WAIT_V(0);
    PG8_BAR;
#undef PG8_KLOOP
#undef PG8_SA
#undef PG8_SB
#undef PG8_STAGE
#undef PG8_STAGE_A
#undef PG8_LDA
#undef PG8_LDB
#undef PG8_MMA
#undef PG8_WAIT_V
#undef PG8_WAIT_L
#undef PG8_BAR
#undef PG8_SCHED
}
}
#include <hip/hip_bf16.h>
#include <cmath>
namespace attn_body {
using bf16=__hip_bfloat16;
using bf16x8=__attribute__((ext_vector_type(8)))short;
using s16x4=__attribute__((ext_vector_type(4)))short;
using f32x16=__attribute__((ext_vector_type(16)))float;
using u32x4=__attribute__((ext_vector_type(4)))unsigned;
constexpr int BATCH=2,NHEAD=16,SEQ=8192,D=64,DM=NHEAD*D,KVR=8256;
constexpr int NW=8,QBLK=32,QB=QBLK*NW,KVBLK=64,NQB=SEQ/QB;
constexpr int ATTN_PITCH=DM, ATTN_UNIT_ROWS=QB;
__device__ __forceinline__ int crow(int r,int hi){return (r&3)+8*(r>>2)+4*hi;}
#define SBAR() __builtin_amdgcn_sched_barrier(0)
__device__ __forceinline__ void cmask(f32x16&p0,f32x16&p1,int jb,int qrel,int hi){
  const float NEG=-INFINITY; int kb=64*jb+4*hi;
  #pragma unroll
  for(int r=0;r<16;++r){int kv=kb+(r&3)+8*(r>>2); if(kv>qrel)p0[r]=NEG; if(kv+32>qrel)p1[r]=NEG;}
}

constexpr int NSLOT=3, SLOTB=8192;
constexpr int LDS_K=0, LDS_V=NSLOT*SLOTB, LDS_WS=2*NSLOT*SLOTB, LDS_OST=LDS_WS+NW*64*4, LDS_BYTES=LDS_OST+NW*4096;
constexpr float C2=0.125f*1.4426950408889634f;
__device__ __forceinline__ void glds16(const void*gsrc,unsigned lds_dst){unsigned keep;
  asm volatile("s_mov_b32 %0, m0\n\ts_mov_b32 m0, %2\n\ts_nop 0\n\tglobal_load_lds_dwordx4 %1, off\n\ts_mov_b32 m0, %0":"=&s"(keep):"v"(gsrc),"s"(lds_dst):"memory");}
__device__ __forceinline__ float max3f(float a,float b,float c){float r;asm("v_max3_f32 %0, %1, %2, %3":"=v"(r):"v"(a),"v"(b),"v"(c));return r;}
__device__ __forceinline__ float max2f(float a,float b){float r;asm("v_max_f32_e32 %0, %1, %2":"=v"(r):"v"(a),"v"(b));return r;}
__device__ __forceinline__ float fadd_s(float a,float b){float r;asm("v_add_f32_e32 %0, %1, %2":"=v"(r):"v"(a),"v"(b));return r;}
__device__ __forceinline__ float fsub_s(float a,float b){float r;asm("v_sub_f32_e32 %0, %1, %2":"=v"(r):"v"(a),"v"(b));return r;}
typedef float f32x2_t __attribute__((ext_vector_type(2))); typedef __bf16 bf16x2_t __attribute__((ext_vector_type(2)));
__device__ __forceinline__ unsigned cvtpk_s(float lo,float hi){f32x2_t v={lo,hi};bf16x2_t b=__builtin_convertvector(v,bf16x2_t);return __builtin_bit_cast(unsigned,b);}
#define WAIT_BAR(N) asm volatile("s_waitcnt vmcnt(" #N ") lgkmcnt(0)\n\ts_barrier":::"memory")

__device__ __forceinline__ void qkt(f32x16&p0,f32x16&p1,const char*Kslot,const bf16x8*qr,const f32x16&n0,const f32x16&n1,int r32,int hi){
  const char*kb=Kslot+hi*1024+r32*16;
  #pragma unroll
  for(int d0=0;d0<4;++d0){
    const bf16x8 b0=*reinterpret_cast<const bf16x8*>(kb+d0*2048);
    const bf16x8 b1=*reinterpret_cast<const bf16x8*>(kb+d0*2048+512);
    if(d0==0){p0=__builtin_amdgcn_mfma_f32_32x32x16_bf16(b0,qr[0],n0,0,0,0);p1=__builtin_amdgcn_mfma_f32_32x32x16_bf16(b1,qr[0],n1,0,0,0);}
    else{p0=__builtin_amdgcn_mfma_f32_32x32x16_bf16(b0,qr[d0],p0,0,0,0);p1=__builtin_amdgcn_mfma_f32_32x32x16_bf16(b1,qr[d0],p1,0,0,0);}}
}
typedef __attribute__((address_space(3))) const char* lds_cptr;
typedef short v4i16_t __attribute__((ext_vector_type(4)));
__device__ __forceinline__ void kload8(bf16x8*kf,lds_cptr kp){
  kf[0]=*(const __attribute__((address_space(3))) bf16x8*)(kp);      kf[1]=*(const __attribute__((address_space(3))) bf16x8*)(kp+512);
  kf[2]=*(const __attribute__((address_space(3))) bf16x8*)(kp+2048); kf[3]=*(const __attribute__((address_space(3))) bf16x8*)(kp+2560);
  kf[4]=*(const __attribute__((address_space(3))) bf16x8*)(kp+4096); kf[5]=*(const __attribute__((address_space(3))) bf16x8*)(kp+4608);
  kf[6]=*(const __attribute__((address_space(3))) bf16x8*)(kp+6144); kf[7]=*(const __attribute__((address_space(3))) bf16x8*)(kp+6656);
}
__device__ __forceinline__ void kload2(bf16x8*kf,lds_cptr kp,int j){ kf[2*j]=*(const __attribute__((address_space(3))) bf16x8*)(kp+j*2048); kf[2*j+1]=*(const __attribute__((address_space(3))) bf16x8*)(kp+j*2048+512); }
__device__ __forceinline__ s16x4 vtr(lds_cptr p){ return __builtin_bit_cast(s16x4,__builtin_amdgcn_ds_read_tr16_b64_v4i16((__attribute__((address_space(3))) v4i16_t*)p)); }
__device__ __forceinline__ float rowmax(const f32x16&p0,const f32x16&p1){
  float a=max3f(p0[0],p0[1],p1[0]),b=max3f(p0[2],p0[3],p1[1]);a=max3f(a,p1[2],p1[3]);
  #pragma unroll
  for(int r=4;r<16;r+=4){a=max3f(a,p0[r],p0[r+1]);b=max3f(b,p0[r+2],p0[r+3]);a=max3f(a,p1[r],p1[r+1]);b=max3f(b,p1[r+2],p1[r+3]);}
  const float m=max2f(a,b);
  auto rr=__builtin_amdgcn_permlane32_swap(__float_as_uint(m),__float_as_uint(m),false,false);
  return max2f(__uint_as_float(rr[0]),__uint_as_float(rr[1]));
}
__device__ __forceinline__ void pv(f32x16*o,int vb,bf16x8 pa0,bf16x8 pa1,bf16x8 pa2,bf16x8 pa3){
  #pragma unroll
  for(int d0=0;d0<2;++d0){s16x4 lo[4],hi[4];
    #pragma unroll
    for(int ks=0;ks<4;++ks){
      asm volatile("ds_read_b64_tr_b16 %0,%1 offset:%c2":"=&v"(lo[ks]):"v"(vb),"i"(d0*4096+ks*1024):"memory");
      asm volatile("ds_read_b64_tr_b16 %0,%1 offset:%c2":"=&v"(hi[ks]):"v"(vb),"i"(d0*4096+ks*1024+512):"memory");}
    asm volatile("s_waitcnt lgkmcnt(0)":::"memory");SBAR();
    #define PK(k) (bf16x8){lo[k][0],lo[k][1],lo[k][2],lo[k][3],hi[k][0],hi[k][1],hi[k][2],hi[k][3]}
    o[d0]=__builtin_amdgcn_mfma_f32_32x32x16_bf16(pa0,PK(0),o[d0],0,0,0);
    o[d0]=__builtin_amdgcn_mfma_f32_32x32x16_bf16(pa1,PK(1),o[d0],0,0,0);
    o[d0]=__builtin_amdgcn_mfma_f32_32x32x16_bf16(pa2,PK(2),o[d0],0,0,0);
    o[d0]=__builtin_amdgcn_mfma_f32_32x32x16_bf16(pa3,PK(3),o[d0],0,0,0);
    #undef PK
  }
}

#ifndef ATTN_STORE16
#define ATTN_STORE16(p,v) (*(u32x4*)(p)=(v))
#endif

__device__ __forceinline__ void attn_finish(const f32x16 (&o)[2],float l_reg,bf16*Ow,char*shm,int wid,int lane){
  const int r32=lane&31,hi=lane>>5; float*wsf=(float*)(shm+LDS_WS)+wid*64;
  {auto rr=__builtin_amdgcn_permlane32_swap(__float_as_uint(l_reg),__float_as_uint(l_reg),false,false);l_reg=__uint_as_float(rr[0])+__uint_as_float(rr[1]);}
  if(hi==0)wsf[32+r32]=l_reg;asm volatile("s_waitcnt lgkmcnt(0)":::"memory");
  float rli[16];
  #pragma unroll
  for(int r=0;r<16;++r)rli[r]=__builtin_amdgcn_rcpf(wsf[32+crow(r,hi)]);
  { bf16*stg=(bf16*)(shm+LDS_OST)+wid*2048;
    #pragma unroll
    for(int r=0;r<16;++r){const int orow=crow(r,hi);
      #pragma unroll
      for(int d0=0;d0<2;++d0)stg[orow*64+d0*32+r32]=__float2bfloat16(o[d0][r]*rli[r]);}
    asm volatile("s_waitcnt lgkmcnt(0)":::"memory");
    #pragma unroll
    for(int i=0;i<4;++i){const int row=i*8+(lane>>3),ch=lane&7; const u32x4 v=*(const u32x4*)(stg+row*64+ch*8); ATTN_STORE16(Ow+(long)row*DM+ch*8,v);} }
}
typedef float f32x4_t __attribute__((ext_vector_type(4)));
template<int THRL> __device__ __forceinline__ void attn_unit(int b,int h,int qb,const bf16*Q,const bf16*__restrict__ K,const bf16*__restrict__ V,bf16*O,char*shm,const __attribute__((address_space(3))) float*fk,const __attribute__((address_space(3))) float*fq,int tile0,int NT,bool band,float*pdump){
  const int tid=threadIdx.x,lane=tid&63,r32=lane&31,hi=lane>>5; const int wid=__builtin_amdgcn_readfirstlane(tid>>6);
  const long rowbase=(long)b*SEQ, kvbase=(long)b*KVR; const int q0=qb*QB;
  const bf16*Qw=Q+(rowbase+q0+wid*QBLK)*DM+h*D;
  const bf16*Kh=K+(kvbase+64*tile0)*DM+h*D,*Vh=V+(kvbase+64*tile0)*DM+h*D;
  const unsigned lds0=(unsigned)(uintptr_t)shm;
  float*wsf=(float*)(shm+LDS_WS)+wid*64;
  const bf16*ksrc=Kh+(long)lane*DM+wid*8;
  const bf16*vsrc=Vh+(long)(16*(wid&3)+(lane>>2))*DM+(wid>>2)*32+(lane&3)*8;
  const unsigned kdst=lds0+LDS_K+wid*1024, vdst=lds0+LDS_V+wid*1024;
  #define DMA_K(t,slot) glds16(ksrc+(long)(t)*KVBLK*DM,(unsigned)__builtin_amdgcn_readfirstlane(kdst+(slot)))
  #define DMA_V(t,slot) glds16(vsrc+(long)(t)*KVBLK*DM,(unsigned)__builtin_amdgcn_readfirstlane(vdst+(slot)))
  const int vb0=(int)(lds0+LDS_V)+((lane>>4)&1)*32+(lane&3)*8+(4*hi+((lane&15)>>2))*64;
  const char*Kbase=shm+LDS_K; bf16x8 kf[8];
  const lds_cptr shm3=(lds_cptr)shm; const lds_cptr kp0=shm3+LDS_K+hi*1024+r32*16; const lds_cptr vp0=shm3+LDS_V+((lane>>4)&1)*32+(lane&3)*8+(4*hi+((lane&15)>>2))*64;
  DMA_K(0,0);DMA_V(0,0);DMA_K(1,SLOTB);
  bf16x8 qr[4];
  #pragma unroll
  for(int d0=0;d0<4;++d0)qr[d0]=*reinterpret_cast<const bf16x8*>(&Qw[(long)r32*DM+d0*16+hi*8]);
  float l_reg=0.f;f32x16 o[2];o[0]=f32x16{};o[1]=f32x16{};
  const float qf=fq[wid*QBLK+r32];
  #define NBLD(N0,N1,t) do{ const __attribute__((address_space(3))) f32x4_t*fp_=(const __attribute__((address_space(3))) f32x4_t*)(fk+64*(t)+4*hi); \
    _Pragma("unroll") for(int g_=0;g_<4;++g_){ const f32x4_t a_=fp_[2*g_], b_=fp_[2*g_+8]; \
      _Pragma("unroll") for(int i_=0;i_<4;++i_){ N0[4*g_+i_]=qf-a_[i_]; N1[4*g_+i_]=qf-b_[i_]; } } }while(0)
  const int qrel=wid*QBLK+r32;
  #define CMASK(P0,P1,t) do{int jb_=(t)-(NT-4); if(band&&jb_>=0)cmask(P0,P1,jb_,qrel,hi);}while(0)
  #define START(P0,P1) do{ _Pragma("unroll") for(int r=0;r<16;++r)P0[r]=__builtin_amdgcn_exp2f(P0[r]); }while(0)
  #define RESC() do{}while(0)
  f32x16 pA0,pA1,pB0,pB1;
  int sl_prev=0,sl_cur=0,sl_next=SLOTB;
  #define ROT() do{sl_prev=sl_cur;sl_cur=sl_next;sl_next=(sl_next==(NSLOT-1)*SLOTB)?0:sl_next+SLOTB;}while(0)
  DMA_K(2,2*SLOTB);
  WAIT_BAR(3);
  { f32x16 nb0_,nb1_; NBLD(nb0_,nb1_,0); qkt(pA0,pA1,Kbase,qr,nb0_,nb1_,r32,hi); }asm volatile("s_nop 15\n\ts_nop 7":"+v"(pA0),"+v"(pA1));CMASK(pA0,pA1,0);
  START(pA0,pA1);
  _Pragma("unroll") for(int r=0;r<16;++r)pA1[r]=__builtin_amdgcn_exp2f(pA1[r]);
  WAIT_BAR(0);
  DMA_K(3,0);DMA_V(1,SLOTB);
  ROT();
  kload8(kf,kp0+sl_cur);
  WAIT_BAR(2);
  s16x4 vlo[8],vhi[8]; u32x4 pw0,pw1,pw2,pw3;
  #define PKW(P,B) cvtpk_s(P[B],P[B+1])
  #define PAF(k) __builtin_bit_cast(bf16x8,pw##k)
  #define VFR(i) (bf16x8){vlo[i][0],vlo[i][1],vlo[i][2],vlo[i][3],vhi[i][0],vhi[i][1],vhi[i][2],vhi[i][3]}
  #define PIN(x) asm volatile("":"+v"(x))
  #define MX3(a,b,c) __builtin_fmaxf(__builtin_fmaxf((a),(b)),(c))
  #define GAPA(MF,A0,A1,A2,A3,W0,W1,PW) do{ MF; sacc+=A0; sacc+=A1; sacc+=A2; sacc+=A3; PIN(sacc); W0; W1; PIN(PW); SBAR(); }while(0)
  #define EX(v) __builtin_amdgcn_exp2f(v)
  #define GAPB(MF,X,B) do{ MF; X[B]=EX(X[B]); X[B+1]=EX(X[B+1]); X[B+2]=EX(X[B+2]); X[B+3]=EX(X[B+3]); PIN(X); SBAR(); }while(0)
  #define VRD(i) do{ vlo[i]=vtr(vp_+(((i)>>2)*4096+((i)&3)*1024)); vhi[i]=vtr(vp_+(((i)>>2)*4096+((i)&3)*1024+512)); }while(0)
  #define KRD(G,j) do{ if(G){ kload2(kf,kp0+sl_next,j); SBAR(); } }while(0)
  #define STEP(C0,C1,P0,P1,t,GK,GV,GL) do{ SBAR(); \
    f32x16 nb0_,nb1_; NBLD(nb0_,nb1_,t); SBAR(); \
    const lds_cptr vp_=vp0+sl_prev; \
    VRD(0); SBAR(); float sacc=(P0[0]+P0[1]); \
    GAPA(C0=__builtin_amdgcn_mfma_f32_32x32x16_bf16(kf[0],qr[0],nb0_,0,0,0), P0[2],P0[3],P0[4],P0[5],     pw0[0]=PKW(P0,0), pw0[1]=PKW(P0,2), pw0); \
    VRD(4); SBAR(); GAPA(C1=__builtin_amdgcn_mfma_f32_32x32x16_bf16(kf[1],qr[0],nb1_,0,0,0), P0[6],P0[7],P0[8],P0[9],     pw0[2]=PKW(P0,4), pw0[3]=PKW(P0,6), pw0); \
    VRD(1); SBAR(); GAPA(C0=__builtin_amdgcn_mfma_f32_32x32x16_bf16(kf[2],qr[1],C0,0,0,0),   P0[10],P0[11],P0[12],P0[13], pw1[0]=PKW(P0,8), pw1[1]=PKW(P0,10), pw1); \
    VRD(5); SBAR(); GAPA(C1=__builtin_amdgcn_mfma_f32_32x32x16_bf16(kf[3],qr[1],C1,0,0,0),   P0[14],P0[15],P1[0],P1[1],   pw1[2]=PKW(P0,12),pw1[3]=PKW(P0,14), pw1); \
    VRD(2); SBAR(); GAPA(C0=__builtin_amdgcn_mfma_f32_32x32x16_bf16(kf[4],qr[2],C0,0,0,0),   P1[2],P1[3],P1[4],P1[5],     pw2[0]=PKW(P1,0), pw2[1]=PKW(P1,2), pw2); \
    VRD(6); SBAR(); GAPA(C1=__builtin_amdgcn_mfma_f32_32x32x16_bf16(kf[5],qr[2],C1,0,0,0),   P1[6],P1[7],P1[8],P1[9],     pw2[2]=PKW(P1,4), pw2[3]=PKW(P1,6), pw2); \
    VRD(3); SBAR(); GAPA(C0=__builtin_amdgcn_mfma_f32_32x32x16_bf16(kf[6],qr[3],C0,0,0,0),   P1[10],P1[11],P1[12],P1[13], pw3[0]=PKW(P1,8), pw3[1]=PKW(P1,10), pw3); \
    VRD(7); SBAR(); GAPA(C1=__builtin_amdgcn_mfma_f32_32x32x16_bf16(kf[7],qr[3],C1,0,0,0),   P1[14],P1[15],0.f,0.f,       pw3[2]=PKW(P1,12),pw3[3]=PKW(P1,14), pw3); \
    l_reg+=sacc; \
    if(GK){DMA_K((t)+3,sl_cur);} if(GV){DMA_V((t)+1,sl_next);} \
    CMASK(C0,C1,t); \
    SBAR(); \
    GAPB(o[0]=__builtin_amdgcn_mfma_f32_32x32x16_bf16(PAF(0),VFR(0),o[0],0,0,0), C0,0); \
    GAPB(o[1]=__builtin_amdgcn_mfma_f32_32x32x16_bf16(PAF(0),VFR(4),o[1],0,0,0), C0,4); \
    KRD(GL,0); GAPB(o[0]=__builtin_amdgcn_mfma_f32_32x32x16_bf16(PAF(1),VFR(1),o[0],0,0,0), C0,8); \
    KRD(GL,1); GAPB(o[1]=__builtin_amdgcn_mfma_f32_32x32x16_bf16(PAF(1),VFR(5),o[1],0,0,0), C0,12); \
    KRD(GL,2); GAPB(o[0]=__builtin_amdgcn_mfma_f32_32x32x16_bf16(PAF(2),VFR(2),o[0],0,0,0), C1,0); \
    KRD(GL,3); GAPB(o[1]=__builtin_amdgcn_mfma_f32_32x32x16_bf16(PAF(2),VFR(6),o[1],0,0,0), C1,4); \
    GAPB(o[0]=__builtin_amdgcn_mfma_f32_32x32x16_bf16(PAF(3),VFR(3),o[0],0,0,0), C1,8); \
    GAPB(o[1]=__builtin_amdgcn_mfma_f32_32x32x16_bf16(PAF(3),VFR(7),o[1],0,0,0), C1,12); \
    }while(0)
  int t=1;
  #undef CMASK
  #define CMASK(P0,P1,t) do{}while(0)
  for(;t+5<NT;t+=2){
    STEP(pB0,pB1,pA0,pA1,t,true,true,true);     WAIT_BAR(2); RESC(); ROT();
    STEP(pA0,pA1,pB0,pB1,t+1,true,true,true);   WAIT_BAR(2); RESC(); ROT();
  }
  #undef CMASK
  #define CMASK(P0,P1,t) do{int jb_=(t)-(NT-4); if(band&&jb_>=0)cmask(P0,P1,jb_,qrel,hi);}while(0)
  #define ENDW(tt) do{ if((tt)+3<NT){WAIT_BAR(2);} else if((tt)+2<NT){WAIT_BAR(1);} else {WAIT_BAR(0);} }while(0)
  for(;t+1<NT;t+=2){
    STEP(pB0,pB1,pA0,pA1,t,(t+3<NT),(t+1<NT),(t+1<NT));       ENDW(t);   RESC(); ROT();
    STEP(pA0,pA1,pB0,pB1,t+1,(t+4<NT),(t+2<NT),(t+2<NT));     ENDW(t+1); RESC(); ROT();
  }
  { float sacc=pA0[0]+pA0[1]; _Pragma("unroll") for(int r=2;r<16;++r)sacc+=pA0[r]; _Pragma("unroll") for(int r=0;r<16;++r)sacc+=pA1[r]; l_reg+=sacc;
    pw0=(u32x4){PKW(pA0,0),PKW(pA0,2),PKW(pA0,4),PKW(pA0,6)};pw1=(u32x4){PKW(pA0,8),PKW(pA0,10),PKW(pA0,12),PKW(pA0,14)};pw2=(u32x4){PKW(pA1,0),PKW(pA1,2),PKW(pA1,4),PKW(pA1,6)};pw3=(u32x4){PKW(pA1,8),PKW(pA1,10),PKW(pA1,12),PKW(pA1,14)};
    SBAR(); pv(o,vb0+sl_prev,PAF(0),PAF(1),PAF(2),PAF(3)); }
  #undef PKW
  #undef PAF
  #undef VFR
  #undef PIN
  #undef MX3
  #undef GAPA
  #undef GAPB
  #undef EX
  #undef VRD
  #undef KRD
  #undef STEP
  #undef ENDW
  if(pdump){ float*pd=pdump+(size_t)wid*33*64+lane;
    #pragma unroll
    for(int d0=0;d0<2;++d0)
      #pragma unroll
      for(int r=0;r<16;++r)pd[(d0*16+r)*64]=o[d0][r];
    pd[32*64]=l_reg; }
  else attn_finish(o,l_reg,O+(rowbase+q0+wid*QBLK)*DM+h*D,shm,wid,lane);
  asm volatile("s_waitcnt lgkmcnt(0)\n\ts_barrier":::"memory");
  #undef DMA_K
  #undef DMA_V
  #undef CMASK
  #undef START
  #undef NBLD
  #undef RESC
  #undef ROT
}
constexpr int ATTN_LDS_BYTES=LDS_BYTES;
struct AttnTensors { const bf16* Q; const bf16* K; const bf16* V; bf16* O; };
struct AttnUnit { int bh; int qb; };
struct StaticOrder {
  int vcu;
  __device__ __forceinline__ explicit StaticOrder(int grid,int block):vcu((block%8)*(grid/8)+block/8){}
  __device__ __forceinline__ bool next(int i,AttnUnit&u)const{ if(i>=4)return false; const int s=vcu&7; u.bh=vcu>>3; u.qb=(i==0)?s:(i==1)?15-s:(i==2)?16+s:31-s; return true; }
  __device__ __forceinline__ void a_ready(const AttnUnit&)const{}
  __device__ __forceinline__ void done(const AttnUnit&)const{}
};
#undef SBAR
#undef WAIT_BAR
}
#define GAS __attribute__((address_space(1)))
#define LAS __attribute__((address_space(3)))
typedef unsigned short bf16;
typedef unsigned v4u __attribute__((ext_vector_type(4)));
typedef float f32x4 __attribute__((ext_vector_type(4)));
typedef short bf16x8 __attribute__((ext_vector_type(8)));
typedef GAS unsigned gu32;
typedef GAS unsigned long long gu64;
#define RLX_AGENT __ATOMIC_RELAXED, __HIP_MEMORY_SCOPE_AGENT
#define LDS_WAIT() asm volatile("s_waitcnt lgkmcnt(0)" ::: "memory")
#define LDS_BARRIER() asm volatile("s_waitcnt lgkmcnt(0)\n\ts_barrier" ::: "memory")
#define VM_WAIT() asm volatile("s_waitcnt vmcnt(0)" ::: "memory")
__device__ __forceinline__ unsigned long long rt() { return __builtin_amdgcn_s_memrealtime(); }
__device__ __forceinline__ unsigned f2bf(float f) { unsigned u = __builtin_bit_cast(unsigned, f); return (u + 0x7fffu + ((u >> 16) & 1u)) >> 16; }
__device__ __forceinline__ unsigned pk2(float lo, float hi) { return f2bf(lo) | (f2bf(hi) << 16); }
typedef __bf16 bf16v2_t __attribute__((ext_vector_type(2)));
typedef float f32v2_t __attribute__((ext_vector_type(2)));
__device__ __forceinline__ unsigned pk2h(float lo, float hi) { const f32v2_t v = {lo, hi}; const bf16v2_t b = __builtin_convertvector(v, bf16v2_t); return __builtin_bit_cast(unsigned, b); }

#define XB_TMO      128
#define XB_XCNT(j)  (256  + 64 * (j))
#define XB_XSUB(j)  (1280 + 64 * (j))
#define XB_XGEN(j)  (2304 + 64 * (j))
#define XB_TOP      3328
#define XB_TOPGEN   3392
#define XCD_BAR_WORDS 3456
#define XB_SPIN_CAP (1u << 18)

__device__ __forceinline__ unsigned xb_ld(unsigned* p)              { return __hip_atomic_load(p, __ATOMIC_RELAXED, __HIP_MEMORY_SCOPE_AGENT); }
__device__ __forceinline__ unsigned xb_add(unsigned* p, unsigned v) { return __hip_atomic_fetch_add(p, v, __ATOMIC_RELAXED, __HIP_MEMORY_SCOPE_AGENT); }
__device__ __forceinline__ unsigned xb_xcc_id() { return (unsigned)__builtin_amdgcn_s_getreg((3 << 11) | 20) & 0xFu; }
#define XB_SPIN(cond, bar) do { unsigned _sp = 0; while (cond) { __builtin_amdgcn_s_sleep(1); \
    if ((++_sp & 255u) == 0u) { if (xb_ld(&(bar)[XB_TMO])) break; if (_sp > XB_SPIN_CAP) { atomicAdd(&(bar)[XB_TMO], 1u); break; } } } } while (0)

struct XcdBarrier {
    unsigned* bar; unsigned x;
    volatile LAS unsigned* st;
};

__device__ __forceinline__ XcdBarrier xcd_barrier_post(unsigned* bar, volatile LAS unsigned* st) {
    XcdBarrier b; b.bar = bar; b.x = xb_xcc_id(); b.st = st;
    if (threadIdx.x == 0) (void)xb_add(&bar[XB_XCNT(b.x)], 1u);
    return b;
}
__device__ __forceinline__ void xcd_barrier_complete(unsigned* bar, unsigned x, unsigned& nloc, unsigned& nx) {
    const unsigned G = gridDim.x * gridDim.y * gridDim.z;
    unsigned sum, cnt, mine, sp = 0u;
    for (;;) {
        sum = 0u; cnt = 0u; mine = 0u;
#pragma unroll
        for (unsigned j = 0; j < 16; ++j) { const unsigned c = xb_ld(&bar[XB_XCNT(j)]); sum += c; cnt += (c > 0u) ? 1u : 0u; mine = (j == x) ? c : mine; }
        if (sum == G) break;
        __builtin_amdgcn_s_sleep(1);
        if ((++sp & 255u) == 0u) { if (xb_ld(&bar[XB_TMO])) break; if (sp > XB_SPIN_CAP) { atomicAdd(&bar[XB_TMO], 1u); break; } }
    }
    nloc = mine > 0u ? mine : 1u; nx = cnt > 0u ? cnt : 1u;
}

__device__ __forceinline__ void xcd_barrier(const XcdBarrier& b) {
    asm volatile("s_waitcnt vmcnt(0)" ::: "memory");
    __syncthreads();
    if (threadIdx.x == 0) {
        unsigned* bar = b.bar;
        __builtin_amdgcn_s_waitcnt(0);
        unsigned nloc = b.st[0], nx = b.st[1];
        if (nloc == 0u) { xcd_barrier_complete(bar, b.x, nloc, nx); b.st[0] = nloc; b.st[1] = nx; }
        const unsigned old = xb_add(&bar[XB_XSUB(b.x)], 1u);
        const unsigned gen = old / nloc;
        if (old + 1u == (gen + 1u) * nloc) {
            __builtin_amdgcn_fence(__ATOMIC_RELEASE, "agent");
            asm volatile("s_waitcnt vmcnt(0)" ::: "memory");
            const unsigned og = xb_add(&bar[XB_TOP], 1u);
            const unsigned tg = og / nx;
            if (og + 1u == (tg + 1u) * nx) xb_add(&bar[XB_TOPGEN], 1u);
            else XB_SPIN(xb_ld(&bar[XB_TOPGEN]) == tg, bar);
            __builtin_amdgcn_fence(__ATOMIC_ACQUIRE, "agent");
            xb_add(&bar[XB_XGEN(b.x)], 1u);
            asm volatile("s_waitcnt vmcnt(0)" ::: "memory");
        } else {
            XB_SPIN(xb_ld(&bar[XB_XGEN(b.x)]) == gen, bar);
            __builtin_amdgcn_fence(__ATOMIC_ACQUIRE, "agent");
            asm volatile("s_waitcnt vmcnt(0)" ::: "memory");
        }
    }
    __syncthreads();
}

constexpr int DM = 1024, SEQ = 8192, NBATCH = 2, TR = NBATCH * SEQ, NMETA = 16, TALL = TR + NMETA, TPAD = TR + 256, LPOS = SEQ + NMETA, KVROWS = 8256;
constexpr int NWAVES = 8;
constexpr int NPHASE = 14;
#ifndef MK_N_LAUNCHES
#define MK_N_LAUNCHES 1
#endif
constexpr int N_LAUNCHES = MK_N_LAUNCHES;

constexpr size_t MiB = 1u << 20;
constexpr size_t WS_CTL = 0, CTL_ZERO_BYTES = 1 * MiB;
constexpr size_t WS_WIN = 2 * MiB, WS_WOUT = 8 * MiB, WS_WKV = 10 * MiB, WS_WQ = 14 * MiB, WS_WO = 16 * MiB;
constexpr size_t WS_GATES = 18 * MiB;
constexpr size_t WS_RS = 19 * MiB;
constexpr size_t WS_TOKP = 19 * MiB + 128 * 1024;
constexpr size_t WS_FM = 20 * MiB;
constexpr size_t WS_FA = 20 * MiB + 512 * 1024;
constexpr size_t WS_LOGF = 22 * MiB;
constexpr size_t WS_LIST = 23 * MiB + 512 * 1024;
constexpr size_t WS_XN = 26 * MiB;
constexpr size_t WS_H1 = 59 * MiB;
constexpr size_t WS_PROJ = 59 * MiB;
constexpr size_t WS_XQ = 59 * MiB, WS_K = 92 * MiB, WS_V = 125 * MiB, WS_Q = 158 * MiB, WS_AO = WS_Q;
constexpr size_t WS_W1T = 192 * MiB, WS_W2T = 224 * MiB;
constexpr size_t WS_ACT = 92 * MiB;
constexpr size_t WS_KVL = 174 * MiB + 512 * 1024;
constexpr size_t WS_CIN = 157 * MiB;
constexpr int LISTCAP = 16400;
constexpr int CW_BAR = 4096;
constexpr int CW_CNT = 16384;
constexpr int CW_RDY = 20480;

constexpr int RING_OFF = 0, RING_BYTES = 139264;
constexpr int LDSCTL_OFF = RING_BYTES, MISC_OFF = LDSCTL_OFF + 320;
constexpr int LDS_BYTES = 159744;

typedef unsigned short bf16;
typedef unsigned v4u __attribute__((ext_vector_type(4)));
typedef unsigned v2u __attribute__((ext_vector_type(2)));
typedef float f32x4 __attribute__((ext_vector_type(4)));
typedef short rp_bf16x8 __attribute__((ext_vector_type(8)));

__device__ __forceinline__ float wave_sum(float v) {
#pragma unroll
    for (int o = 1; o < 64; o <<= 1) v += __shfl_xor(v, o);
    return v;
}
__device__ __forceinline__ float wave_max(float v) {
#pragma unroll
    for (int o = 1; o < 64; o <<= 1) v = fmaxf(v, __shfl_xor(v, o));
    return v;
}
__device__ __forceinline__ float bflo(unsigned u) { return __uint_as_float(u << 16); }
__device__ __forceinline__ float bfhi(unsigned u) { return __uint_as_float(u & 0xffff0000u); }
__device__ __forceinline__ float log_sigmoidf(float x) { return fminf(x, 0.f) - log1pf(expf(-fabsf(x))); }
__device__ __forceinline__ float dot4(f32x4 a, f32x4 b) { return (a.x * b.x + a.y * b.y) + (a.z * b.z + a.w * b.w); }
__device__ __forceinline__ float dot8bf(v4u a, v4u b) {
    return (bflo(a.x) * bflo(b.x) + bfhi(a.x) * bfhi(b.x)) + (bflo(a.y) * bflo(b.y) + bfhi(a.y) * bfhi(b.y)) +
           (bflo(a.z) * bflo(b.z) + bfhi(a.z) * bfhi(b.z)) + (bflo(a.w) * bflo(b.w) + bfhi(a.w) * bfhi(b.w));
}
__device__ __forceinline__ unsigned long long pack4bf(f32x4 v) { return (unsigned long long)pk2(v.x, v.y) | ((unsigned long long)pk2(v.z, v.w) << 32); }


template <int N> __device__ __forceinline__ float reduce_scatter(float (&s)[N], int lane) {
    int n = N, k = 0;
#pragma unroll
    for (; n > 1; n >>= 1, ++k) {
        const bool up = (lane >> k) & 1;
#pragma unroll
        for (int i = 0; i < n / 2; ++i) { const float a = s[i], b = s[i + n / 2]; const float keep = up ? b : a, send = up ? a : b; s[i] = keep + __shfl_xor(send, 1 << k); }
    }
    float t = s[0];
#pragma unroll
    for (int o = N; o < 64; o <<= 1) t += __shfl_xor(t, o);
    return t;
}
template <int N> __host__ __device__ constexpr int rsc_lane(int c) {
    int l = 0, bits = 0; for (int n = N; n > 1; n >>= 1) ++bits;
    for (int k = 0; k < bits; ++k) l |= ((c >> (bits - 1 - k)) & 1) << k;
    return l;
}
template <int NC, int NP> __device__ __forceinline__ float row_dots_rs(const f32x4 (&v)[4], const LAS float* Wl, int lane) {
    float s[NP];
#pragma unroll
    for (int c = 0; c < NP; ++c) { s[c] = 0.f;
        if (c < NC) {
#pragma unroll
            for (int j = 0; j < 4; ++j) s[c] += dot4(v[j], ((const LAS f32x4*)(Wl + c * 1024))[lane + 64 * j]); } }
    return reduce_scatter<NP>(s, lane);
}

template <int NC> __device__ __forceinline__ float row_dots(const f32x4 (&v)[4], const LAS float* Wl, int lane) {
    float val = 0.f;
#pragma unroll 1
    for (int c0 = 0; c0 < NC; c0 += 4) {
        float s[4];
#pragma unroll
        for (int g = 0; g < 4; ++g) { s[g] = 0.f;
#pragma unroll
            for (int j = 0; j < 4; ++j) s[g] += dot4(v[j], ((const LAS f32x4*)(Wl + (c0 + g) * 1024))[lane + 64 * j]); }
#pragma unroll
        for (int o = 1; o < 64; o <<= 1) {
#pragma unroll
            for (int g = 0; g < 4; ++g) s[g] += __shfl_xor(s[g], o); }
#pragma unroll
        for (int g = 0; g < 4; ++g) val = (lane == c0 + g) ? s[g] : val;
    }
    return val;
}
__device__ __forceinline__ void transpose_item(const float* W, int K, int N, int ldw, bf16* WT, LAS float* scr, int item, int lane, int ldt = 0, const float* gain = nullptr) {
    if (ldt == 0) ldt = K;
    const int nblk = N / 32, kb = item / nblk, nb = item % nblk, k0 = 64 * kb, n0 = 32 * nb;
    f32x4 t4[8];
#pragma unroll
    for (int i = 0; i < 8; ++i) { const int idx = i * 64 + lane; t4[i] = *(const f32x4*)(W + (size_t)(k0 + (idx >> 3)) * ldw + n0 + (idx & 7) * 4); }
    if (gain) {
#pragma unroll
        for (int i = 0; i < 8; ++i) t4[i] = t4[i] * gain[k0 + ((i * 64 + lane) >> 3)]; }
#pragma unroll
    for (int i = 0; i < 8; ++i) { const int idx = i * 64 + lane; LAS float* d = scr + (idx >> 3) * 33 + (idx & 7) * 4; d[0] = t4[i][0]; d[1] = t4[i][1]; d[2] = t4[i][2]; d[3] = t4[i][3]; }
    LDS_WAIT(); asm volatile("" ::: "memory");
    const int c = lane & 7;
#pragma unroll
    for (int j = 0; j < 4; ++j) { const int n = (lane >> 3) + 8 * j; const LAS float* s = scr + (8 * c) * 33 + n;
        v4u o; o.x = pk2(s[0 * 33], s[1 * 33]); o.y = pk2(s[2 * 33], s[3 * 33]); o.z = pk2(s[4 * 33], s[5 * 33]); o.w = pk2(s[6 * 33], s[7 * 33]);
        *(GAS v4u*)(WT + (size_t)(n0 + n) * ldt + k0 + 8 * c) = o; }
    LDS_WAIT(); asm volatile("" ::: "memory");
}

struct TrPtrs { const float *w_in, *w_out, *kv_w, *w_q, *w_o, *mw_gate, *mw_up, *mw_down, *gkv, *gq1, *gffn; bf16 *Win_t, *Wout_t, *Wkv_t, *Wq_t, *Wo_t, *W1t, *W2t; };
struct TrItem { const float* src; bf16* dst; const float* gain; int ldw, ldt, d2; };
template <int SET> __device__ __forceinline__ TrItem tr_decode(const TrPtrs& P, int idx) {
    constexpr int I_IN = 16 * 96, I_SQ = 16 * 32, I_KV = 16 * 64;
    TrItem d; const float* W; bf16* WT; int N, ldw, ldt = 1024, item; const float* gain = nullptr; d.d2 = 0;
    const int kind = SET == 0 ? (idx < 4096 ? 0 : (idx < 8192 ? 1 : 2)) : (idx < 4096 ? 1 : 2);
    if (kind == 0) { int r = idx;
        if (r < I_IN) { W = P.w_in; N = 3072; ldw = 3080; WT = P.Win_t; item = r; }
        else if ((r -= I_IN) < I_SQ) { W = P.w_out; N = 1024; ldw = 1024; WT = P.Wout_t; item = r; }
        else if ((r -= I_SQ) < I_KV) { W = P.kv_w; N = 2048; ldw = 2064; WT = P.Wkv_t; item = r; gain = P.gkv; }
        else if ((r -= I_KV) < I_SQ) { W = P.w_q; N = 1024; ldw = 1024; WT = P.Wq_t; item = r; gain = P.gq1; }
        else { r -= I_SQ; W = P.w_o; N = 1024; ldw = 1024; WT = P.Wo_t; item = r; } }
    else if (kind == 1) { const int j = SET == 0 ? idx - 4096 : 4096 + idx, mat = j >> 7, which = mat & 1, le = mat >> 1; item = ((j & 15) << 3) | ((j & 127) >> 4); const int fblk = (item & 7) >> 2;
        W = (which ? P.mw_up : P.mw_gate) + (size_t)le * 1024 * 256; N = 256; ldw = 256; WT = P.W1t + ((size_t)(le * 2 + fblk) * 256 + which * 128 - fblk * 128) * 1024; gain = P.gffn + (le >> 4) * DM; }
    else { const int j = SET == 0 ? idx - 8192 : 2048 + (idx - 4096), lb = j >> 7, L = lb >> 4, grp = (lb >> 2) & 3, ex = lb & 3; item = (j & 3) * 32 + ((j & 127) >> 2);
        const int bi2 = ex == 0 ? 4 : (ex == 1 ? 6 : (ex == 2 ? 5 : 7));
        W = P.mw_down + (size_t)(L * 16 + grp * 4 + ex) * 256 * 1024; N = 1024; ldw = 1024; WT = P.W2t + (size_t)L * 1024 * 8192 + (grp * 8 + ex) * 256; ldt = 8192; d.d2 = (bi2 - ex) * 256; }
    const int nblk = N / 32, kb = item / nblk, nb = item - kb * nblk, k0 = 64 * kb, n0 = 32 * nb;
    d.src = W + (size_t)k0 * ldw + n0; d.dst = WT + (size_t)n0 * ldt + k0; d.gain = gain ? gain + k0 : nullptr; d.ldw = ldw; d.ldt = ldt; return d;
}
template <int SET> __device__ __forceinline__ void ph_transposes(const TrPtrs& P, LAS float* scr, int w, int NW, int lane, int lo = 0, int hi = (SET == 0 ? 10240 : 6144)) {
    const int NITEMS = hi;
    f32x4 t4[8]; float gn[8];
    int it = lo + w;
    TrItem cur = tr_decode<SET>(P, it < NITEMS ? it : 0);
    if (it < NITEMS) {
#pragma unroll
        for (int i = 0; i < 8; ++i) { const int idx = i * 64 + lane; t4[i] = __builtin_nontemporal_load((const f32x4*)(cur.src + (size_t)(idx >> 3) * cur.ldw + (idx & 7) * 4)); gn[i] = cur.gain ? cur.gain[idx >> 3] : 1.f; } }
#pragma unroll 1
    for (; it < NITEMS; it += NW) {
        const bool has = it + NW < NITEMS;
        const TrItem nxt = tr_decode<SET>(P, has ? it + NW : it);
        f32x4 t4n[8]; float gnn[8];
        if (has) {
#pragma unroll
            for (int i = 0; i < 8; ++i) { const int idx = i * 64 + lane; t4n[i] = __builtin_nontemporal_load((const f32x4*)(nxt.src + (size_t)(idx >> 3) * nxt.ldw + (idx & 7) * 4)); gnn[i] = nxt.gain ? nxt.gain[idx >> 3] : 1.f; } }
        else {
#pragma unroll
            for (int i = 0; i < 8; ++i) { t4n[i] = t4[i]; gnn[i] = gn[i]; } }
#pragma unroll
        for (int i = 0; i < 8; ++i) { const int idx = i * 64 + lane; LAS float* dd = scr + (idx >> 3) * 33 + (idx & 7) * 4; const f32x4 v = t4[i] * gn[i]; dd[0] = v[0]; dd[1] = v[1]; dd[2] = v[2]; dd[3] = v[3]; }
        LDS_WAIT(); asm volatile("" ::: "memory");
        const int c = lane & 7;
#pragma unroll
        for (int j = 0; j < 4; ++j) { const int n = (lane >> 3) + 8 * j; const LAS float* s = scr + (8 * c) * 33 + n;
            v4u o; o.x = pk2h(s[0 * 33], s[1 * 33]); o.y = pk2h(s[2 * 33], s[3 * 33]); o.z = pk2h(s[4 * 33], s[5 * 33]); o.w = pk2h(s[6 * 33], s[7 * 33]);
            bf16* dp = cur.dst + (size_t)n * cur.ldt + 8 * c;
            *(GAS v4u*)dp = o;
            if (cur.d2) *(GAS v4u*)(dp + cur.d2) = o; }
        LDS_WAIT(); asm volatile("" ::: "memory");
        cur = nxt;
#pragma unroll
        for (int i = 0; i < 8; ++i) { t4[i] = t4n[i]; gn[i] = gnn[i]; }
    }
}

__device__ __forceinline__ void ph_prologue(const float* x, const float* meta, const float* gmix0, const float* w_in, const float* b_gate, const TrPtrs& TP, bf16* XN, float* gates,
                                            LAS unsigned char* lds, int gw, int NGW, int tid, int lane, int wave) {
    LAS float* Wl = (LAS float*)lds;
    LAS float* scr = (LAS float*)(lds + 32768 + wave * 8704);
    const bool rows_first = ((gw >> 3) & 1) != 0;
    if (!rows_first) ph_transposes<0>(TP, scr, gw, NGW, lane, 0, 8192);
    __syncthreads();
    {
        LAS bf16* Bl1 = (LAS bf16*)lds;
        LAS bf16* Bl2 = (LAS bf16*)(lds + 16384);
        LAS float* ssq = (LAS float*)(lds + 32768);
        LAS f32x4* part = (LAS f32x4*)(lds + 33792);
        for (int d = tid; d < 1024; d += 512) { const float gd = gmix0[d];
#pragma unroll
            for (int q = 0; q < 2; ++q) { const f32x4 w4 = *(const f32x4*)(w_in + (size_t)d * 3080 + 3072 + 4 * q);
#pragma unroll
                for (int e = 0; e < 4; ++e) { const float w = w4[e] * gd; const unsigned hi1 = f2bf(w); Bl1[(4 * q + e) * 1024 + d] = (bf16)hi1; Bl2[(4 * q + e) * 1024 + d] = (bf16)f2bf(w - __uint_as_float(hi1 << 16)); } } }
        __syncthreads();
        const int r16 = lane & 15, g4 = lane >> 4, kb = wave * 128 + 8 * g4, vcu_ = gw >> 3;
        const int ntile = vcu_ == 0 ? 5 : 4;
        f32x4 gg[4][2];
#pragma unroll
        for (int ks = 0; ks < 4; ++ks) { gg[ks][0] = *(const f32x4*)(gmix0 + kb + 32 * ks); gg[ks][1] = *(const f32x4*)(gmix0 + kb + 32 * ks + 4); }
        const float bgate = b_gate[(tid >> 2) & 7];
        f32x4 hv[4][2];
        { const float* src = x + (size_t)(vcu_ * 64 + r16) * DM + kb;
#pragma unroll
          for (int ks = 0; ks < 4; ++ks) { hv[ks][0] = __builtin_nontemporal_load((const f32x4*)(src + 32 * ks)); hv[ks][1] = __builtin_nontemporal_load((const f32x4*)(src + 32 * ks + 4)); } }
#pragma unroll 1
        for (int it = 0; it < ntile; ++it) {
            const int R0 = it < 4 ? vcu_ * 64 + it * 16 : TR;
            const int row = R0 + r16;
            f32x4 hn[4][2];
            { const int rown = (it + 1 < 4 ? vcu_ * 64 + (it + 1) * 16 : TR) + r16; const float* srcn = (rown < TR ? x + (size_t)rown * DM : meta + (size_t)(rown - TR) * DM) + kb;
              if (it + 1 < ntile) {
#pragma unroll
                  for (int ks = 0; ks < 4; ++ks) { hn[ks][0] = __builtin_nontemporal_load((const f32x4*)(srcn + 32 * ks)); hn[ks][1] = __builtin_nontemporal_load((const f32x4*)(srcn + 32 * ks + 4)); } }
              else {
#pragma unroll
                  for (int ks = 0; ks < 4; ++ks) { hn[ks][0] = hv[ks][0]; hn[ks][1] = hv[ks][1]; } } }
            float ss = 0.f;
#pragma unroll
            for (int ks = 0; ks < 4; ++ks) ss += dot4(hv[ks][0], hv[ks][0]) + dot4(hv[ks][1], hv[ks][1]);
            ss += __shfl_xor(ss, 16); ss += __shfl_xor(ss, 32);
            if (g4 == 0) ssq[(it & 1) * 128 + wave * 16 + r16] = ss;
            f32x4 acc = {0.f, 0.f, 0.f, 0.f};
            const int colc = r16 < 8 ? r16 : 7;
#pragma unroll
            for (int ks = 0; ks < 4; ++ks) {
                unsigned p1[4], p2[4];
#pragma unroll
                for (int q = 0; q < 4; ++q) { const float x0 = hv[ks][q >> 1][(q & 1) * 2], x1 = hv[ks][q >> 1][(q & 1) * 2 + 1];
                    p1[q] = pk2h(x0, x1);
                    p2[q] = pk2h(x0 - __uint_as_float(p1[q] << 16), x1 - __uint_as_float(p1[q] & 0xffff0000u)); }
                const rp_bf16x8 A1 = __builtin_bit_cast(rp_bf16x8, (v4u){p1[0], p1[1], p1[2], p1[3]}), A2 = __builtin_bit_cast(rp_bf16x8, (v4u){p2[0], p2[1], p2[2], p2[3]});
                const rp_bf16x8 B1 = *(const LAS rp_bf16x8*)(Bl1 + colc * 1024 + kb + 32 * ks), B2 = *(const LAS rp_bf16x8*)(Bl2 + colc * 1024 + kb + 32 * ks);
                acc = __builtin_amdgcn_mfma_f32_16x16x32_bf16(A1, B1, acc, 0, 0, 0);
                acc = __builtin_amdgcn_mfma_f32_16x16x32_bf16(A1, B2, acc, 0, 0, 0);
                acc = __builtin_amdgcn_mfma_f32_16x16x32_bf16(A2, B1, acc, 0, 0, 0);
            }
            part[(it & 1) * 512 + wave * 64 + lane] = acc;
            LDS_BARRIER();
            float rstd_own;
            { float q = 0.f;
#pragma unroll
              for (int w = 0; w < 8; ++w) q += ssq[(it & 1) * 128 + w * 16 + r16];
              rstd_own = rsqrtf(q * (1.f / DM) + 1e-6f); }
            if (tid < 256) { const int ln = tid >> 2, i = tid & 3, rr = 4 * (ln >> 4) + i, cc = ln & 15;
                if (cc < 8) { float sacc = 0.f, q = 0.f;
#pragma unroll
                    for (int w = 0; w < 8; ++w) { sacc += ((const LAS float*)(part + (it & 1) * 512))[(w * 64 + ln) * 4 + i]; q += ssq[(it & 1) * 128 + w * 16 + rr]; }
                    float val = sacc * rsqrtf(q * (1.f / DM) + 1e-6f) + bgate; val = 15.f * tanhf(val * (1.f / 15.f)); if (cc >= 4) val = log_sigmoidf(val);
                    gates[(size_t)(R0 + rr) * 8 + cc] = val; } }
#pragma unroll
            for (int ks = 0; ks < 4; ++ks) { const f32x4 y0 = hv[ks][0] * rstd_own * gg[ks][0], y1 = hv[ks][1] * rstd_own * gg[ks][1];
                v4u o; o.x = pk2h(y0[0], y0[1]); o.y = pk2h(y0[2], y0[3]); o.z = pk2h(y1[0], y1[1]); o.w = pk2h(y1[2], y1[3]);
                *(v4u*)(XN + (size_t)row * DM + kb + 32 * ks) = o; }
#pragma unroll
            for (int ks = 0; ks < 4; ++ks) { hv[ks][0] = hn[ks][0]; hv[ks][1] = hn[ks][1]; }
        }
    }
    if (rows_first) { __syncthreads(); ph_transposes<0>(TP, scr, gw, NGW, lane, 0, 8192); }
}

__device__ __forceinline__ void scan_seq(const float* src, int ld, int off, int nh, int nseq, float* Fout, int gw, int NGW, int lane) {
    for (int sq = gw; sq < nseq; sq += NGW) {
        const int b = sq / nh, h = sq % nh, p0 = lane * 129;
        float s = 0.f;
        for (int i = 0; i < 129; ++i) { const int p = p0 + i; if (p < LPOS) { const int row = p < NMETA ? TR + p : b * SEQ + p - NMETA; s += src[(size_t)row * ld + off + h]; } }
        float incl = s;
#pragma unroll
        for (int o = 1; o < 64; o <<= 1) { const float t = __shfl_up(incl, o); if (lane >= o) incl += t; }
        float run = incl - s;
        for (int i = 0; i < 129; ++i) { const int p = p0 + i; if (p < LPOS) { const int row = p < NMETA ? TR + p : b * SEQ + p - NMETA; run += src[(size_t)row * ld + off + h]; Fout[(size_t)sq * LPOS + p] = run; } }
    }
}

__device__ __forceinline__ void ph_mlstm_naive(const bf16* PROJ, const float* gates, const float* Fm, const float* g_out, bf16* HM, int gw, int NGW, int lane) {
    for (int it = gw; it < 4 * TALL; it += NGW) {
        const int r = it >> 2, h = it & 3;
        const int b = r < TR ? r / SEQ : 0, p = r < TR ? NMETA + (r % SEQ) : r - TR;
        const float* Fb = Fm + (size_t)(b * 4 + h) * LPOS; const float Fp = Fb[p];
        v4u q[16];
#pragma unroll
        for (int i = 0; i < 16; ++i) q[i] = ((const v4u*)(PROJ + (size_t)r * 3072 + h * 128))[i];
        float acc0 = 0.f, acc1 = 0.f, acc2 = 0.f, acc3 = 0.f, den = 0.f;
        const int nchunk = p / 64 + 1;
        for (int c = 0; c < nchunk; ++c) {
            const int s = c * 64 + lane; const bool valid = s <= p; const int sc = valid ? s : p;
            const int krow = sc < NMETA ? TR + sc : b * SEQ + sc - NMETA;
            const v4u* kp = (const v4u*)(PROJ + (size_t)krow * 3072 + 512 + h * 128);
            float d = 0.f;
#pragma unroll
            for (int i = 0; i < 16; ++i) d += dot8bf(q[i], kp[i]);
            const float w = valid ? __expf(Fp - Fb[sc] + gates[(size_t)krow * 8 + h]) : 0.f;
            const float cv = w * d; den += cv;
            const int jmax = (p - c * 64) < 63 ? (p - c * 64) : 63;
            for (int j = 0; j <= jmax; ++j) {
                const float cj = __shfl(cv, j); const int sj = c * 64 + j;
                const int vrow = sj < NMETA ? TR + sj : b * SEQ + sj - NMETA;
                const v2u vv = *(const v2u*)(PROJ + (size_t)vrow * 3072 + 1024 + h * 256 + lane * 4);
                acc0 += cj * bflo(vv.x); acc1 += cj * bfhi(vv.x); acc2 += cj * bflo(vv.y); acc3 += cj * bfhi(vv.y);
            }
        }
        den = wave_sum(den);
        const float dn = 1.f / fmaxf(fabsf(den), 1.f);
        acc0 *= dn; acc1 *= dn; acc2 *= dn; acc3 *= dn;
        const float ss = wave_sum((acc0 * acc0 + acc1 * acc1) + (acc2 * acc2 + acc3 * acc3));
        const float rstd = rsqrtf(ss * (1.f / 256.f) + 1e-6f);
        const v2u ov = *(const v2u*)(PROJ + (size_t)r * 3072 + 2048 + h * 256 + lane * 4);
        const f32x4 gv = *(const f32x4*)(g_out + h * 256 + lane * 4);
        f32x4 o;
        o.x = acc0 * rstd * gv.x / (1.f + __expf(-bflo(ov.x))); o.y = acc1 * rstd * gv.y / (1.f + __expf(-bfhi(ov.x)));
        o.z = acc2 * rstd * gv.z / (1.f + __expf(-bflo(ov.y))); o.w = acc3 * rstd * gv.w / (1.f + __expf(-bfhi(ov.y)));
        *(unsigned long long*)(HM + (size_t)r * DM + h * 256 + lane * 4) = pack4bf(o);
    }
}

__device__ __forceinline__ void ph_norm_router(const bf16* H, int nrows, const float* g, const float* w_group, const float* b_group, const float* w_router, const float* b_router,
                                               float* LP, gu32* cnt, int* list, LAS unsigned char* lds, int vcu, int tid, int lane, int wave) {
    LAS bf16* Bl1 = (LAS bf16*)lds;
    LAS bf16* Bl2 = (LAS bf16*)(lds + 40960);
    LAS float* ssq = (LAS float*)(lds + 81920);
    LAS f32x4* part = (LAS f32x4*)(lds + 82944);
    LAS float* lgt = (LAS float*)(lds + 115712);
    LAS float* rsl = (LAS float*)(lds + 125952);
    LAS int* hist = (LAS int*)(lds + 126336);
    LAS int* gbase = hist + 32;
    LAS int* rinfo = hist + 64;
    LAS int* bkl = hist + 144;
    LAS float* bia = (LAS float*)(hist + 224);
    LAS f32x4* rpi = (LAS f32x4*)(hist + 256);
    for (int d = tid; d < 1024; d += 512) {
        const float gd = g[d]; const f32x4 wg4 = ((const f32x4*)w_group)[d];
        float w[20];
#pragma unroll
        for (int e = 0; e < 4; ++e) w[e] = wg4[e] * gd;
#pragma unroll
        for (int q = 0; q < 4; ++q) { const f32x4 wr4 = ((const f32x4*)w_router)[4 * d + q];
#pragma unroll
            for (int e = 0; e < 4; ++e) w[4 + 4 * q + e] = wr4[e] * gd; }
#pragma unroll
        for (int c = 0; c < 20; ++c) { const unsigned hi1 = f2bf(w[c]); const float res = w[c] - __uint_as_float(hi1 << 16); Bl1[c * 1024 + d] = (bf16)hi1; Bl2[c * 1024 + d] = (bf16)f2bf(res); }
    }
    if (tid < 24) hist[tid] = 0;
    if (tid < 80) rinfo[tid] = -1;
    if (tid >= 128 && tid < 148) bia[tid - 128] = tid < 132 ? b_group[tid - 128] : b_router[tid - 132];
    __syncthreads();
    const int r16 = lane & 15, g4 = lane >> 4, kb = wave * 128 + 8 * g4;
    const int ntile = (vcu == 0 && nrows > TR) ? 5 : 4;
    v4u hv[4];
    { const bf16* src = H + (size_t)(vcu * 64 + r16) * DM + kb;
#pragma unroll
      for (int ks = 0; ks < 4; ++ks) hv[ks] = *(const v4u*)(src + 32 * ks); }
#pragma unroll 1
    for (int it = 0; it < ntile; ++it) {
        const int R0 = it < 4 ? vcu * 64 + it * 16 : TR;
        v4u hn[4];
        { const bf16* srcn = H + (size_t)((it + 1 < 4 ? vcu * 64 + (it + 1) * 16 : TR) + r16) * DM + kb;
          if (it + 1 < ntile) {
#pragma unroll
              for (int ks = 0; ks < 4; ++ks) hn[ks] = *(const v4u*)(srcn + 32 * ks); }
          else {
#pragma unroll
              for (int ks = 0; ks < 4; ++ks) hn[ks] = hv[ks]; } }
        float ss = 0.f;
#pragma unroll
        for (int ks = 0; ks < 4; ++ks) ss += dot8bf(hv[ks], hv[ks]);
        ss += __shfl_xor(ss, 16); ss += __shfl_xor(ss, 32);
        if (g4 == 0) ssq[(it & 1) * 128 + wave * 16 + r16] = ss;
        f32x4 acc[2] = {{0.f, 0.f, 0.f, 0.f}, {0.f, 0.f, 0.f, 0.f}};
#pragma unroll
        for (int ks = 0; ks < 4; ++ks) {
            const rp_bf16x8 A1 = __builtin_bit_cast(rp_bf16x8, hv[ks]);
#pragma unroll
            for (int t = 0; t < 2; ++t) { int col = 16 * t + r16; col = col < 20 ? col : 19;
                const rp_bf16x8 B1 = *(const LAS rp_bf16x8*)(Bl1 + col * 1024 + kb + 32 * ks), B2 = *(const LAS rp_bf16x8*)(Bl2 + col * 1024 + kb + 32 * ks);
                acc[t] = __builtin_amdgcn_mfma_f32_16x16x32_bf16(A1, B1, acc[t], 0, 0, 0);
                acc[t] = __builtin_amdgcn_mfma_f32_16x16x32_bf16(A1, B2, acc[t], 0, 0, 0); }
        }
        part[(it & 1) * 1024 + (wave * 2 + 0) * 64 + lane] = acc[0]; part[(it & 1) * 1024 + (wave * 2 + 1) * 64 + lane] = acc[1];
        LDS_BARRIER();
        { const int t = tid >> 8, ln = (tid >> 2) & 63, i = tid & 3, rr = 4 * (ln >> 4) + i, cc = 16 * t + (ln & 15);
          float sacc = 0.f, q = 0.f;
#pragma unroll
          for (int w = 0; w < 8; ++w) { sacc += ((const LAS float*)(part + (it & 1) * 1024))[((w * 2 + t) * 64 + ln) * 4 + i]; q += ssq[(it & 1) * 128 + w * 16 + rr]; }
          const float rstd = rsqrtf(q * (1.f / DM) + 1e-6f);
          lgt[(it * 16 + rr) * 32 + cc] = sacc * rstd;
          if (cc == 0) rsl[it * 16 + rr] = rstd; }
#pragma unroll
        for (int ks = 0; ks < 4; ++ks) hv[ks] = hn[ks];
    }
    LDS_BARRIER();
    {
        if (tid < 16 * ntile) {
            const int it = tid >> 4; const int R0 = it < 4 ? vcu * 64 + it * 16 : TR;
            const int r = R0 + (tid & 15); const LAS float* lg = lgt + tid * 32;
            float gl[4];
#pragma unroll
            for (int j = 0; j < 4; ++j) gl[j] = lg[j] + bia[j];
            int tg = 0; float gm = gl[0];
#pragma unroll
            for (int j = 1; j < 4; ++j) if (gl[j] > gm) { gm = gl[j]; tg = j; }
            float gs = 0.f;
#pragma unroll
            for (int j = 0; j < 4; ++j) gs += __expf(gl[j] - gm);
            const float pg = 1.f / gs;
            float el[4];
#pragma unroll
            for (int j = 0; j < 4; ++j) el[j] = lg[4 + 4 * tg + j] + bia[4 + 4 * tg + j];
            int i1 = 0; float v1 = el[0];
#pragma unroll
            for (int j = 1; j < 4; ++j) if (el[j] > v1) { v1 = el[j]; i1 = j; }
            int i2 = -1; float v2 = -3.0e38f;
#pragma unroll
            for (int j = 0; j < 4; ++j) if (j != i1 && el[j] > v2) { v2 = el[j]; i2 = j; }
            const float e21 = __expf(v2 - v1), p1 = pg / (1.f + e21), p2 = pg * e21 / (1.f + e21);
            const int lo = i1 < i2 ? i1 : i2, hi = i1 < i2 ? i2 : i1;
            const int pi = lo == 0 ? hi - 1 : (lo == 1 ? hi + 1 : 5);
            const int bkt = tg * 6 + pi;
            __hip_atomic_fetch_add(hist + bkt, 1, __ATOMIC_RELAXED, __HIP_MEMORY_SCOPE_WORKGROUP);
            bkl[tid] = bkt; rinfo[tid] = r << 16;
            const float rsr = rsl[tid]; rpi[tid] = (f32x4){(i1 < i2 ? p1 : p2) * rsr, (i1 < i2 ? p2 : p1) * rsr, rsr, 0.f};
        }
        LDS_BARRIER();
        if (tid < 16 * ntile) { const int bkt = bkl[tid]; int tk = 0;
            for (int j = 0; j < tid; ++j) tk += (bkl[j] == bkt) ? 1 : 0;
            rinfo[tid] |= (bkt << 8) | tk; }
    }
    __syncthreads();
    if (tid < 24) { const int n = hist[tid]; gbase[tid] = n ? (int)__hip_atomic_fetch_add(cnt + 32 * tid, (unsigned)n, __ATOMIC_RELAXED, __HIP_MEMORY_SCOPE_AGENT) : 0; }
    __syncthreads();
    if (tid < 80) { const int ri = rinfo[tid]; if (ri >= 0) { const int bkt = (ri >> 8) & 255, pos = bkt * LISTCAP + gbase[bkt] + (ri & 255); list[pos] = ri >> 16; ((f32x4*)LP)[pos] = rpi[tid]; } }
}

__device__ __forceinline__ void ph_moe_naive(const bf16* XN, const float* tokp, const gu32* cnt, const int* list, const float* Wg, const float* Wu, const float* Wd,
                                             float* h0, float* h1, LAS unsigned char* lds, int bid, int G, int tid) {
    LAS float* xs = (LAS float*)lds;
    LAS float* hu = (LAS float*)(lds + 65536);
    LAS float* act = (LAS float*)(lds + 65536 + 16384);
    LAS int* tks = (LAS int*)(lds + 65536 + 32768);
    int ntl[16]; int total = 0;
#pragma unroll
    for (int e = 0; e < 16; ++e) { const int c = (int)__hip_atomic_load(cnt + e, __ATOMIC_RELAXED, __HIP_MEMORY_SCOPE_AGENT); ntl[e] = (c + 15) >> 4; total += ntl[e]; }
    for (int g = bid; g < total; g += G) {
        int e = 0, ti = g;
#pragma unroll
        for (int k = 0; k < 16; ++k) { if (e == k && ti >= ntl[k]) { ti -= ntl[k]; e = k + 1; } }
        const int ce = (int)__hip_atomic_load(cnt + e, __ATOMIC_RELAXED, __HIP_MEMORY_SCOPE_AGENT);
        const int nv = (ce - ti * 16) < 16 ? (ce - ti * 16) : 16;
        __syncthreads();
        if (tid < 16) tks[tid] = tid < nv ? list[e * LISTCAP + ti * 16 + tid] : -1;
        __syncthreads();
        for (int i = tid; i < 16 * 512; i += 512) { const int t = i >> 9, c2 = i & 511; const int tk = tks[t];
            float a = 0.f, b2 = 0.f; if (tk >= 0) { const unsigned u = *(const unsigned*)(XN + (size_t)(tk >> 1) * DM + 2 * c2); a = bflo(u); b2 = bfhi(u); }
            xs[t * 1024 + 2 * c2] = a; xs[t * 1024 + 2 * c2 + 1] = b2; }
        __syncthreads();
        const int which = tid >> 8, f = tid & 255;
        const float* W = (which ? Wu : Wg) + (size_t)e * 1024 * 256 + f;
        float a16[16];
#pragma unroll
        for (int t = 0; t < 16; ++t) a16[t] = 0.f;
        for (int k = 0; k < 1024; k += 4) {
            const float w0 = W[(size_t)k * 256], w1 = W[(size_t)(k + 1) * 256], w2 = W[(size_t)(k + 2) * 256], w3 = W[(size_t)(k + 3) * 256];
#pragma unroll
            for (int t = 0; t < 16; ++t) { const f32x4 xv = *(const LAS f32x4*)(xs + t * 1024 + k); a16[t] += (xv.x * w0 + xv.y * w1) + (xv.z * w2 + xv.w * w3); }
        }
        if (which) {
#pragma unroll
            for (int t = 0; t < 16; ++t) hu[t * 256 + f] = a16[t];
        }
        __syncthreads();
        if (!which) {
#pragma unroll
            for (int t = 0; t < 16; ++t) { const int tk = tks[t]; const float p = tk >= 0 ? tokp[tk] : 0.f; const float gte = a16[t];
                act[t * 256 + f] = gte / (1.f + __expf(-gte)) * hu[t * 256 + f] * p; }
        }
        __syncthreads();
        float y0[16], y1[16];
#pragma unroll
        for (int t = 0; t < 16; ++t) { y0[t] = 0.f; y1[t] = 0.f; }
        const float* D0 = Wd + (size_t)e * 256 * 1024 + tid;
        for (int k = 0; k < 256; k += 4) {
            float wa[4], wb[4];
#pragma unroll
            for (int i = 0; i < 4; ++i) { wa[i] = D0[(size_t)(k + i) * 1024]; wb[i] = D0[(size_t)(k + i) * 1024 + 512]; }
#pragma unroll
            for (int t = 0; t < 16; ++t) { const f32x4 av = *(const LAS f32x4*)(act + t * 256 + k);
                y0[t] += (av.x * wa[0] + av.y * wa[1]) + (av.z * wa[2] + av.w * wa[3]); y1[t] += (av.x * wb[0] + av.y * wb[1]) + (av.z * wb[2] + av.w * wb[3]); }
        }
#pragma unroll
        for (int t = 0; t < 16; ++t) { const int tk = tks[t]; if (tk >= 0) { const int r = tk >> 1; float* hp = r < TR ? h0 + (size_t)r * DM : h1 + (size_t)(r - TR) * DM;
                hp[tid] += y0[t]; hp[tid + 512] += y1[t]; } }
    }
    __syncthreads();
}

__device__ __forceinline__ void ph_norm_kvq(const bf16* H, const float* gkv, const float* kv_w, const float* b_f, float* RS, float* logf, bf16* K, bf16* V,
                                            LAS unsigned char* lds, int vcu, int gw, int NGW, int tid, int lane, int wave) {
    for (int i = gw; i < 4 * 48; i += NGW) { bf16* base = (i & 1) ? V : K; const int bb = (i >> 1) & 1, rr = 16 + (i >> 2); v4u z = {0u, 0u, 0u, 0u};
        ((v4u*)(base + ((size_t)bb * KVROWS + rr) * DM))[2 * lane] = z; ((v4u*)(base + ((size_t)bb * KVROWS + rr) * DM))[2 * lane + 1] = z; }
    LAS bf16* Bl1 = (LAS bf16*)lds;
    LAS bf16* Bl2 = (LAS bf16*)(lds + 32768);
    LAS float* ssq = (LAS float*)(lds + 65536);
    LAS f32x4* part = (LAS f32x4*)(lds + 66560);
    for (int d = tid; d < 1024; d += 512) {
        const float gd = gkv[d];
#pragma unroll
        for (int q = 0; q < 4; ++q) { const f32x4 w4 = *(const f32x4*)(kv_w + (size_t)d * 2064 + 2048 + 4 * q);
#pragma unroll
            for (int e = 0; e < 4; ++e) { const float w = w4[e] * gd; const unsigned hi1 = f2bf(w); Bl1[(4 * q + e) * 1024 + d] = (bf16)hi1; Bl2[(4 * q + e) * 1024 + d] = (bf16)f2bf(w - __uint_as_float(hi1 << 16)); } }
    }
    __syncthreads();
    const int r16 = lane & 15, g4 = lane >> 4, kb = wave * 128 + 8 * g4;
    const int ntile = vcu == 0 ? 5 : 4;
    const float bfv = b_f[(tid >> 2) & 15];
    v4u hv[4];
    { const bf16* src = H + (size_t)(vcu * 64 + r16) * DM + kb;
#pragma unroll
      for (int ks = 0; ks < 4; ++ks) hv[ks] = *(const v4u*)(src + 32 * ks); }
#pragma unroll 1
    for (int it = 0; it < ntile; ++it) {
        const int R0 = it < 4 ? vcu * 64 + it * 16 : TR;
        v4u hn[4];
        { const bf16* srcn = H + (size_t)((it + 1 < 4 ? vcu * 64 + (it + 1) * 16 : TR) + r16) * DM + kb;
          if (it + 1 < ntile) {
#pragma unroll
              for (int ks = 0; ks < 4; ++ks) hn[ks] = *(const v4u*)(srcn + 32 * ks); }
          else {
#pragma unroll
              for (int ks = 0; ks < 4; ++ks) hn[ks] = hv[ks]; } }
        float ss = 0.f;
#pragma unroll
        for (int ks = 0; ks < 4; ++ks) ss += dot8bf(hv[ks], hv[ks]);
        ss += __shfl_xor(ss, 16); ss += __shfl_xor(ss, 32);
        if (g4 == 0) ssq[(it & 1) * 128 + wave * 16 + r16] = ss;
        f32x4 acc = {0.f, 0.f, 0.f, 0.f};
#pragma unroll
        for (int ks = 0; ks < 4; ++ks) {
            const rp_bf16x8 A1 = __builtin_bit_cast(rp_bf16x8, hv[ks]);
            const rp_bf16x8 B1 = *(const LAS rp_bf16x8*)(Bl1 + r16 * 1024 + kb + 32 * ks), B2 = *(const LAS rp_bf16x8*)(Bl2 + r16 * 1024 + kb + 32 * ks);
            acc = __builtin_amdgcn_mfma_f32_16x16x32_bf16(A1, B1, acc, 0, 0, 0);
            acc = __builtin_amdgcn_mfma_f32_16x16x32_bf16(A1, B2, acc, 0, 0, 0);
        }
        part[(it & 1) * 512 + wave * 64 + lane] = acc;
        LDS_BARRIER();
        if (tid < 256) { const int ln = tid >> 2, i = tid & 3, rr = 4 * (ln >> 4) + i, cc = ln & 15;
            float sacc = 0.f, q = 0.f;
#pragma unroll
            for (int w = 0; w < 8; ++w) { sacc += ((const LAS float*)(part + (it & 1) * 512))[(w * 64 + ln) * 4 + i]; q += ssq[(it & 1) * 128 + w * 16 + rr]; }
            const float rstd = rsqrtf(q * (1.f / DM) + 1e-6f);
            logf[(size_t)cc * TPAD + (R0 + rr)] = log_sigmoidf(sacc * rstd + bfv);
            if (cc == 0) RS[R0 + rr] = rstd; }
#pragma unroll
        for (int ks = 0; ks < 4; ++ks) hv[ks] = hn[ks];
    }
}

__device__ __forceinline__ void headnorm_row(bf16* row, const float* g, float scale, int lane) {
    v4u a = ((v4u*)row)[2 * lane], b = ((v4u*)row)[2 * lane + 1];
    float f[16] = {bflo(a.x), bfhi(a.x), bflo(a.y), bfhi(a.y), bflo(a.z), bfhi(a.z), bflo(a.w), bfhi(a.w), bflo(b.x), bfhi(b.x), bflo(b.y), bfhi(b.y), bflo(b.z), bfhi(b.z), bflo(b.w), bfhi(b.w)};
    float ss = 0.f;
#pragma unroll
    for (int i = 0; i < 16; ++i) ss += f[i] * f[i];
    ss += __shfl_xor(ss, 1); ss += __shfl_xor(ss, 2);
    const float rstd = rsqrtf(ss * (1.f / 64.f) + 1e-6f) * scale;
    const float* gp = g + (lane & 3) * 16;
#pragma unroll
    for (int i = 0; i < 16; ++i) f[i] = f[i] * rstd * gp[i];
    a.x = pk2(f[0], f[1]); a.y = pk2(f[2], f[3]); a.z = pk2(f[4], f[5]); a.w = pk2(f[6], f[7]);
    b.x = pk2(f[8], f[9]); b.y = pk2(f[10], f[11]); b.z = pk2(f[12], f[13]); b.w = pk2(f[14], f[15]);
    ((v4u*)row)[2 * lane] = a; ((v4u*)row)[2 * lane + 1] = b;
}
__device__ __forceinline__ void ph_headnorm(bf16* Q, bf16* K, bf16* V, const float* gq, const float* gk, int gw, int NGW, int lane) {
    for (int r = gw; r < TR; r += NGW) headnorm_row(Q + (size_t)r * DM, gq, 0.125f * 1.4426950408889634f, lane);
    for (int i = gw; i < 4 * 48; i += NGW) { bf16* base = (i & 1) ? V : K; const int bb = (i >> 1) & 1, rr = 16 + (i >> 2); v4u z = {0u, 0u, 0u, 0u};
        ((v4u*)(base + ((size_t)bb * KVROWS + rr) * DM))[2 * lane] = z; ((v4u*)(base + ((size_t)bb * KVROWS + rr) * DM))[2 * lane + 1] = z; }
    for (int i = gw; i < NBATCH * LPOS; i += NGW) { const int b = i / LPOS, p = i % LPOS; const int kr = b * KVROWS + (p < NMETA ? p : 48 + p); headnorm_row(K + (size_t)kr * DM, gk, 1.f, lane); }
}

__device__ __forceinline__ void ph_attn_naive(const bf16* Q, const bf16* K, const bf16* V, const float* Fa, bf16* AO, int gw, int NGW, int lane) {
    for (int it = gw; it < NBATCH * 16 * SEQ; it += NGW) {
        const int h = it & 15, rt = it >> 4, b = rt / SEQ, t = rt % SEQ, p = NMETA + t;
        const float* Fb = Fa + (size_t)(b * 16 + h) * LPOS; const float Fq = Fb[p];
        v4u q[8];
#pragma unroll
        for (int i = 0; i < 8; ++i) q[i] = ((const v4u*)(Q + (size_t)rt * DM + h * 64))[i];
        float m = -3.0e38f, l = 0.f, acc = 0.f;
        const int nchunk = p / 64 + 1;
        for (int c = 0; c < nchunk; ++c) {
            const int s = c * 64 + lane; const bool valid = s <= p; const int sc = valid ? s : p;
            const size_t krow = (size_t)b * KVROWS + (sc < NMETA ? sc : 48 + sc);
            const v4u* kp = (const v4u*)(K + krow * DM + h * 64);
            float d = 0.f;
#pragma unroll
            for (int i = 0; i < 8; ++i) d += dot8bf(q[i], kp[i]);
            const float lg = valid ? d + Fq - Fb[sc] : -3.0e38f;
            const float mn = fmaxf(m, wave_max(lg));
            const float sc_old = __expf(m - mn);
            const float pv = valid ? __expf(lg - mn) : 0.f;
            l = l * sc_old + wave_sum(pv); acc *= sc_old; m = mn;
            const int jmax = (p - c * 64) < 63 ? (p - c * 64) : 63;
            for (int j = 0; j <= jmax; ++j) {
                const float pj = __shfl(pv, j); const int sj = c * 64 + j;
                const size_t vrow = (size_t)b * KVROWS + (sj < NMETA ? sj : 48 + sj);
                acc += pj * __uint_as_float((unsigned)V[vrow * DM + h * 64 + lane] << 16);
            }
        }
        AO[(size_t)rt * DM + h * 64 + lane] = (bf16)f2bf(acc / l);
    }
}

__device__ __forceinline__ void build_fk(const float* logf, int b, int h, LAS float* fk, LAS float* scr, int tid, int lane, int wave) {
    const int p0 = tid * 17;
    float loc[17]; float s = 0.f;
#pragma unroll
    for (int i = 0; i < 17; ++i) { const int p = p0 + i; float v = 0.f; if (p < LPOS) { const int row = p < NMETA ? TR + p : b * SEQ + p - NMETA; v = logf[(size_t)h * TPAD + row]; } loc[i] = v; s += v; }
    float incl = s;
#pragma unroll
    for (int o = 1; o < 64; o <<= 1) { const float t = __shfl_up(incl, o); if (lane >= o) incl += t; }
    __syncthreads();
    if (lane == 63) scr[wave] = incl;
    __syncthreads();
    float base = 0.f;
#pragma unroll
    for (int w = 0; w < 8; ++w) base += (w < wave) ? scr[w] : 0.f;
    float run = base + incl - s;
#pragma unroll
    for (int i = 0; i < 17; ++i) { const int p = p0 + i; if (p < LPOS) { run += loc[i]; fk[p < NMETA ? p : p + 48] = run * 1.4426950408889634f; } }
    if (tid < 48) fk[16 + tid] = __builtin_inff();
    __syncthreads();
}

__device__ __forceinline__ void moe_tables(const gu32* cnt, LAS int* tbl, int tid) {
    __syncthreads();
    if (tid < 24) { const int c = (int)__hip_atomic_load(cnt + 32 * tid, __ATOMIC_RELAXED, __HIP_MEMORY_SCOPE_AGENT); tbl[tid] = (c + 255) >> 8; tbl[32 + tid] = c; }
    __syncthreads();
    if (tid < 128) { int b = -1, t0 = 0, accn = 0;
#pragma unroll 1
        for (int k = 0; k < 24; ++k) { const int n = tbl[k]; if (b < 0 && tid < accn + n) { b = k; t0 = tid - accn; } accn += n; }
        tbl[64 + tid] = b < 0 ? -1 : ((b << 16) | t0);
        if (tid == 0) tbl[60] = accn; }
    __syncthreads();
}

__device__ __forceinline__ void ph_final_add(float* out, const bf16* Y, int gw, int NGW, int lane) {
    for (int r = gw; r < TR; r += NGW) {
#pragma unroll
        for (int j = 0; j < 4; ++j) { const v2u yv = ((const v2u*)(Y + (size_t)r * DM))[lane + 64 * j];
            ((f32x4*)(out + (size_t)r * DM))[lane + 64 * j] += (f32x4){bflo(yv.x), bfhi(yv.x), bflo(yv.y), bfhi(yv.y)}; }
    }
}

__device__ __forceinline__ void ph_fk_scan(const float* logf, const float* gq, const float* gk, float* FK, int* TS, LAS unsigned char* lds, int bx, int tid, int lane, int wave) {
    if (bx < 32) {
        LAS float* scr = (LAS float*)lds;
        LAS int* tsl = (LAS int*)(lds + 128);
        LAS float* fl = (LAS float*)(lds + 1024);
        const int b = bx >> 4, h = bx & 15, p0 = tid * 17;
        float loc[17]; float s = 0.f;
#pragma unroll
        for (int i = 0; i < 17; ++i) { const int p = p0 + i; float v = 0.f; if (p < LPOS) { const int row = p < NMETA ? TR + p : b * SEQ + p - NMETA; v = logf[(size_t)h * TPAD + row]; } loc[i] = v; s += v; }
        float incl = s;
#pragma unroll
        for (int o = 1; o < 64; o <<= 1) { const float t = __shfl_up(incl, o); if (lane >= o) incl += t; }
        __syncthreads();
        if (lane == 63) scr[wave] = incl;
        if (tid < 32) tsl[tid] = 1 << 20;
        if (wave == 1) { const float a = wave_max(fabsf(gq[lane])), c = wave_max(fabsf(gk[lane])); if (lane == 0) scr[16] = 40.f + 2.f * (11.5416f * 1.03f * a * c); }
        __syncthreads();
        float base = 0.f;
#pragma unroll
        for (int w = 0; w < 8; ++w) base += (w < wave) ? scr[w] : 0.f;
        float run = base + incl - s;
        float* fk = FK + (size_t)bx * KVROWS;
#pragma unroll
        for (int i = 0; i < 17; ++i) { const int p = p0 + i; if (p < LPOS) { run += loc[i]; const float v = run * 1.4426950408889634f; const int sl = p < NMETA ? p : p + 48; fk[sl] = v; fl[sl] = v; } }
        if (tid < 48) { fk[16 + tid] = __builtin_inff(); fl[16 + tid] = __builtin_inff(); }
        __syncthreads();
        const float thr = scr[16];
        for (int idx = tid; idx < 32 * 132; idx += 512) { const int qb = idx / 132, t = idx - qb * 132;
            if (t < 4 * qb + 5) { const float d = fl[64 + 256 * qb] - fl[t == 0 ? 15 : 64 * t + 63]; if (d >= -thr) atomicMin((int*)tsl + qb, t); } }
        __syncthreads();
        if (tid < 32) { int ts = tsl[tid]; const int lim = 4 * tid; ts = ts < lim ? ts : lim; TS[bx * 32 + tid] = ts & ~1; }
    }
}

constexpr int ML_NU = 260, ML_PX = 272, ML_PV = 560, ML_ST = 128 * 272;
typedef short bf16x8_t __attribute__((ext_vector_type(8)));
typedef short s16x4_t __attribute__((ext_vector_type(4)));
typedef short v4i16_t __attribute__((ext_vector_type(4)));

__device__ __forceinline__ bf16x8_t tr_frag(const LAS unsigned char* tile, int pitchB, int lane) {
    const LAS unsigned char* p = tile + (8 * (lane >> 4) + ((lane & 15) >> 2)) * pitchB + (lane & 3) * 8;
    const s16x4_t lo = __builtin_bit_cast(s16x4_t, __builtin_amdgcn_ds_read_tr16_b64_v4i16((LAS v4i16_t*)p));
    const s16x4_t hi = __builtin_bit_cast(s16x4_t, __builtin_amdgcn_ds_read_tr16_b64_v4i16((LAS v4i16_t*)(p + 4 * pitchB)));
    return (bf16x8_t){lo[0], lo[1], lo[2], lo[3], hi[0], hi[1], hi[2], hi[3]};
}
__device__ __forceinline__ v4u scale8(v4u a, float s) {
    v4u r; r.x = pk2(bflo(a.x) * s, bfhi(a.x) * s); r.y = pk2(bflo(a.y) * s, bfhi(a.y) * s); r.z = pk2(bflo(a.z) * s, bfhi(a.z) * s); r.w = pk2(bflo(a.w) * s, bfhi(a.w) * s); return r;
}
__device__ __forceinline__ float block_scan256(float v, LAS float* sc, int lane, int wave) {
    float incl = v;
#pragma unroll
    for (int o = 1; o < 64; o <<= 1) { const float t = __shfl_up(incl, o); if (lane >= o) incl += t; }
    __syncthreads();
    if (lane == 63) sc[wave] = incl;
    __syncthreads();
    float base = 0.f;
#pragma unroll
    for (int w = 0; w < 8; ++w) base += (w < wave) ? sc[w] : 0.f;
    return base + incl;
}
struct MlUnit { int h, rowbase, nvalid, meta; };
__device__ __forceinline__ int ml_unit_of(int i, int bx) {
    if (i) return 256 + bx;
    const int q = bx & 7, j = bx >> 3, pm = 8 * q + (j >> 2), h = j & 3;
    return ((pm >> 5) * 4 + h) * 32 + (pm & 31);
}
__device__ __forceinline__ MlUnit ml_unit(int u) {
    MlUnit m;
    if (u < 256) { const int bh = u >> 5, c = u & 31; m.h = bh & 3; m.rowbase = (bh >> 2) * SEQ + c * 256; m.nvalid = 256; m.meta = 0; }
    else { m.h = u - 256; m.rowbase = TR; m.nvalid = NMETA; m.meta = 1; }
    return m;
}

__device__ __forceinline__ void ml_kvloc(const bf16* PROJ, const float* gates, bf16* KV, float* Gt, LAS unsigned char* lds, int bx, int G, int tid, int lane, int wave) {
    LAS float* wgt = (LAS float*)lds;
    LAS float* sc = (LAS float*)(lds + 1024);
    LAS unsigned char* Xs = lds + 2048;
    LAS unsigned char* Vs = lds + 2048 + 64 * ML_PX;
    const int g4 = lane >> 4, c16 = lane & 15;
    for (int iu = 0; iu < (bx < 4 ? 2 : 1); ++iu) {
        const int u = ml_unit_of(iu, bx);
        const MlUnit m = ml_unit(u);
        float lfv = 0.f, igv = -__builtin_inff();
        if (tid < m.nvalid) { lfv = gates[(size_t)(m.rowbase + tid) * 8 + 4 + m.h]; igv = gates[(size_t)(m.rowbase + tid) * 8 + m.h]; }
        v4u kr[2], vr[4];
#pragma unroll
        for (int j = 0; j < 2; ++j) { const int i = tid + 512 * j, s = (i >> 4); kr[j] = (v4u){0u, 0u, 0u, 0u};
            if (s < m.nvalid) kr[j] = *(const v4u*)(PROJ + (size_t)(m.rowbase + s) * 3072 + 512 + m.h * 128 + (i & 15) * 8); }
#pragma unroll
        for (int j = 0; j < 4; ++j) { const int i = tid + 512 * j, s = (i >> 5); vr[j] = (v4u){0u, 0u, 0u, 0u};
            if (s < m.nvalid) vr[j] = *(const v4u*)(PROJ + (size_t)(m.rowbase + s) * 3072 + 1024 + m.h * 256 + (i & 31) * 8); }
        const float bc = block_scan256(tid < 256 ? lfv : 0.f, sc, lane, wave);
        __syncthreads();
        if (tid == 255) sc[8] = bc;
        __syncthreads();
        const float gtot = sc[8];
        if (tid < 256) wgt[tid] = (tid < m.nvalid) ? __expf(gtot - bc + igv) : 0.f;
        if (tid == 0) Gt[u] = gtot;
        f32x4 acc[17];
#pragma unroll
        for (int t = 0; t < 17; ++t) acc[t] = (f32x4){0.f, 0.f, 0.f, 0.f};
        const int nsb = (m.nvalid + 63) >> 6;
        for (int sb = 0; sb < nsb; ++sb) {
            LDS_BARRIER();
#pragma unroll
            for (int j = 0; j < 2; ++j) { const int i = tid + 512 * j; *(LAS v4u*)(Xs + (i >> 4) * ML_PX + (i & 15) * 16) = scale8(kr[j], wgt[sb * 64 + (i >> 4)]); }
#pragma unroll
            for (int j = 0; j < 4; ++j) { const int i = tid + 512 * j; *(LAS v4u*)(Vs + (i >> 5) * ML_PV + (i & 31) * 16) = vr[j]; }
            if (tid < 128) { const int row = tid >> 1, ch = tid & 1; const v4u o = {ch == 0 ? 0x3F80u : 0u, 0u, 0u, 0u}; *(LAS v4u*)(Vs + row * ML_PV + 512 + ch * 16) = o; }
            if (sb + 1 < nsb) {
#pragma unroll
                for (int j = 0; j < 2; ++j) { const int i = tid + 512 * j, s = (sb + 1) * 64 + (i >> 4); kr[j] = (v4u){0u, 0u, 0u, 0u};
                    if (s < m.nvalid) kr[j] = *(const v4u*)(PROJ + (size_t)(m.rowbase + s) * 3072 + 512 + m.h * 128 + (i & 15) * 8); }
#pragma unroll
                for (int j = 0; j < 4; ++j) { const int i = tid + 512 * j, s = (sb + 1) * 64 + (i >> 5); vr[j] = (v4u){0u, 0u, 0u, 0u};
                    if (s < m.nvalid) vr[j] = *(const v4u*)(PROJ + (size_t)(m.rowbase + s) * 3072 + 1024 + m.h * 256 + (i & 31) * 8); }
            }
            LDS_BARRIER();
#pragma unroll
            for (int ks = 0; ks < 2; ++ks) {
                const bf16x8_t a = tr_frag(Xs + (32 * ks) * ML_PX + (16 * wave) * 2, ML_PX, lane);
#pragma unroll
                for (int t = 0; t < 17; ++t) { const bf16x8_t bq = tr_frag(Vs + (32 * ks) * ML_PV + 32 * t, ML_PV, lane); acc[t] = __builtin_amdgcn_mfma_f32_16x16x32_bf16(a, bq, acc[t], 0, 0, 0);
                    if (t & 1) __builtin_amdgcn_sched_barrier(0); }
            }
        }
        { LAS unsigned char* Ot = lds + 55296 + wave * 8704;
#pragma unroll
          for (int t = 0; t < 17; ++t)
#pragma unroll
              for (int i = 0; i < 4; ++i) *(LAS unsigned short*)(Ot + (4 * g4 + i) * 544 + (16 * t + c16) * 2) = (unsigned short)f2bf(acc[t][i]);
          __builtin_amdgcn_sched_barrier(0);
          bf16* outw = KV + (size_t)u * ML_ST + (size_t)(16 * wave) * 272;
#pragma unroll
          for (int n = 0; n < 9; ++n) { const int q = lane + 64 * n; if (q < 544) *(v4u*)(outw + q * 8) = *(const LAS v4u*)(Ot + q * 16); } }
        __syncthreads();
    }
}

__device__ __forceinline__ void ml_scan(const bf16* __restrict__ KV, const float* __restrict__ Gt, bf16* __restrict__ Cin, int bx, int G, int tid) {
    for (int id = bx * 512 + tid; id < 8 * 128 * 68; id += G * 512) {
        const int bh = id / 8704, rem = id - bh * 8704, off = (rem / 68) * 272 + (rem % 68) * 4, h = bh & 3;
        f32x4 C = {0.f, 0.f, 0.f, 0.f};
#pragma unroll 16
        for (int c = 0; c < 32; ++c) {
            const int su = (c == 0) ? 256 + h : bh * 32 + c - 1;
            const v2u kr = *(const v2u*)(KV + (size_t)su * ML_ST + off); const f32x4 kv = {bflo(kr.x), bfhi(kr.x), bflo(kr.y), bfhi(kr.y)};
            const float e = __expf(Gt[su]);
            C = C * e + kv;
            *(unsigned long long*)(Cin + (size_t)(bh * 32 + c) * ML_ST + off) = pack4bf(C);
        }
    }
}

template <class BarFn>
__device__ __forceinline__ void ml_out(const bf16* PROJ, const float* gates, const bf16* Cin, const float* g_out, bf16* HM, LAS unsigned char* lds, int bx, int G, int tid, int lane, int wave, const BarFn& grid_barrier) {
    LAS unsigned char* Cs = lds;
    LAS unsigned char* Vs = lds + 71680;
    LAS unsigned char* Ks = lds + 107520;
    LAS float* bcs = (LAS float*)(lds + 124928);
    LAS float* igs = bcs + 256;
    LAS float* sc = igs + 256;
    LAS unsigned char* Ssc = lds + 127232 + wave * 1280;
    const int g4 = lane >> 4, c16 = lane & 15;
#pragma unroll 1
    for (int iu = 0; iu < 2; ++iu) {
        if (iu == 1) grid_barrier();
        const int u = iu == 0 ? (bx >= G - 4 ? 256 + (bx - (G - 4)) : -1) : ml_unit_of(0, bx);
        if (u < 0) continue;
        const MlUnit m = ml_unit(u);
        float lfv = 0.f, igv = -__builtin_inff();
        if (tid < m.nvalid) { lfv = gates[(size_t)(m.rowbase + tid) * 8 + 4 + m.h]; igv = gates[(size_t)(m.rowbase + tid) * 8 + m.h]; }
        const float bc = block_scan256(tid < 256 ? lfv : 0.f, sc, lane, wave);
        __syncthreads();
        if (tid < 256) { bcs[tid] = bc; igs[tid] = igv; }
        if (!m.meta) for (int i = tid; i < 128 * 34; i += 512) { const int row = i / 34, ch = i - row * 34;
            *(LAS v4u*)(Cs + row * ML_PV + ch * 16) = *(const v4u*)(Cin + (size_t)u * ML_ST + row * 272 + ch * 8); }
        __syncthreads();
        const int nkb = (m.nvalid + 63) >> 6;
#pragma unroll 1
        for (int x = 0; x < (m.meta ? 1 : 2); ++x) {
            const int rt = x ? 15 - wave : wave;
            bf16x8_t qa[4];
            { const bf16* src = PROJ + (size_t)(m.rowbase + 16 * rt + c16) * 3072 + m.h * 128 + 8 * g4;
#pragma unroll
              for (int ks = 0; ks < 4; ++ks) qa[ks] = *(const bf16x8_t*)(src + 32 * ks); }
            f32x4 acc[17];
#pragma unroll
            for (int t = 0; t < 17; ++t) acc[t] = (f32x4){0.f, 0.f, 0.f, 0.f};
            float br[4];
#pragma unroll
            for (int i = 0; i < 4; ++i) br[i] = bcs[16 * rt + 4 * g4 + i];
            v4u kr[2], vr[4];
#pragma unroll
            for (int j = 0; j < 2; ++j) { const int i = tid + 512 * j, s = (i >> 4); kr[j] = (v4u){0u, 0u, 0u, 0u};
                if (s < m.nvalid) kr[j] = *(const v4u*)(PROJ + (size_t)(m.rowbase + s) * 3072 + 512 + m.h * 128 + (i & 15) * 8); }
#pragma unroll
            for (int j = 0; j < 4; ++j) { const int i = tid + 512 * j, s = (i >> 5); vr[j] = (v4u){0u, 0u, 0u, 0u};
                if (s < m.nvalid) vr[j] = *(const v4u*)(PROJ + (size_t)(m.rowbase + s) * 3072 + 1024 + m.h * 256 + (i & 31) * 8); }
            if (!m.meta) {
                const float e0 = __expf(bcs[16 * rt + c16]);
#pragma unroll
                for (int ks = 0; ks < 4; ++ks) {
                    const bf16x8_t p0 = __builtin_bit_cast(bf16x8_t, scale8(__builtin_bit_cast(v4u, qa[ks]), e0));
#pragma unroll
                    for (int t = 0; t < 17; ++t) { const bf16x8_t bq = tr_frag(Cs + (32 * ks) * ML_PV + 32 * t, ML_PV, lane);
                        acc[t] = __builtin_amdgcn_mfma_f32_16x16x32_bf16(p0, bq, acc[t], 0, 0, 0);
                        if ((t & 3) == 3) __builtin_amdgcn_sched_barrier(0); }
                }
            }
            const int nkbx = x ? nkb : (nkb < 2 ? nkb : 2);
            for (int kb = 0; kb < nkbx; ++kb) {
                LDS_BARRIER();
#pragma unroll
                for (int j = 0; j < 2; ++j) { const int i = tid + 512 * j; *(LAS v4u*)(Ks + (i >> 4) * ML_PX + (i & 15) * 16) = kr[j]; }
#pragma unroll
                for (int j = 0; j < 4; ++j) { const int i = tid + 512 * j; *(LAS v4u*)(Vs + (i >> 5) * ML_PV + (i & 31) * 16) = vr[j]; }
                if (tid < 128) { const int row = tid >> 1, ch = tid & 1; const v4u o = {ch == 0 ? 0x3F80u : 0u, 0u, 0u, 0u}; *(LAS v4u*)(Vs + row * ML_PV + 512 + ch * 16) = o; }
                if (kb + 1 < nkbx) {
#pragma unroll
                    for (int j = 0; j < 2; ++j) { const int i = tid + 512 * j, s = (kb + 1) * 64 + (i >> 4); kr[j] = (v4u){0u, 0u, 0u, 0u};
                        if (s < m.nvalid) kr[j] = *(const v4u*)(PROJ + (size_t)(m.rowbase + s) * 3072 + 512 + m.h * 128 + (i & 15) * 8); }
#pragma unroll
                    for (int j = 0; j < 4; ++j) { const int i = tid + 512 * j, s = (kb + 1) * 64 + (i >> 5); vr[j] = (v4u){0u, 0u, 0u, 0u};
                        if (s < m.nvalid) vr[j] = *(const v4u*)(PROJ + (size_t)(m.rowbase + s) * 3072 + 1024 + m.h * 256 + (i & 31) * 8); }
                }
                LDS_BARRIER();
#pragma unroll
                for (int hb = 0; hb < 2; ++hb) {
                    const int s0 = 64 * kb + 32 * hb;
                    if (s0 > 16 * rt + 15) continue;
                    f32x4 sa[2] = {{0.f, 0.f, 0.f, 0.f}, {0.f, 0.f, 0.f, 0.f}};
#pragma unroll
                    for (int ks = 0; ks < 4; ++ks)
#pragma unroll
                        for (int n = 0; n < 2; ++n) { const bf16x8_t bk = *(const LAS bf16x8_t*)(Ks + (32 * hb + 16 * n + c16) * ML_PX + (32 * ks + 8 * g4) * 2);
                            sa[n] = __builtin_amdgcn_mfma_f32_16x16x32_bf16(qa[ks], bk, sa[n], 0, 0, 0); }
#pragma unroll
                    for (int n = 0; n < 2; ++n) { const int s = s0 + 16 * n + c16; const float bs = igs[s] - bcs[s];
#pragma unroll
                        for (int i = 0; i < 4; ++i) { const int r = 16 * rt + 4 * g4 + i; const float e = __expf(br[i] + bs); const float d = (s <= r) ? e : 0.f;
                            *(LAS unsigned short*)(Ssc + (4 * g4 + i) * 80 + (16 * n + c16) * 2) = (unsigned short)(f2bf(sa[n][i] * d)); } }
                    __builtin_amdgcn_sched_barrier(0);
                    const bf16x8_t pf = *(const LAS bf16x8_t*)(Ssc + c16 * 80 + 16 * g4);
#pragma unroll
                    for (int t = 0; t < 17; ++t) { const bf16x8_t bq = tr_frag(Vs + (32 * hb) * ML_PV + 32 * t, ML_PV, lane);
                        acc[t] = __builtin_amdgcn_mfma_f32_16x16x32_bf16(pf, bq, acc[t], 0, 0, 0);
                        if ((t & 3) == 3) __builtin_amdgcn_sched_barrier(0); }
                }
            }
            v4u ovr[2][4];
#pragma unroll
            for (int hf = 0; hf < 2; ++hf)
#pragma unroll
                for (int j = 0; j < 4; ++j) { const int chunk = j * 64 + lane, tr = 16 * rt + (chunk >> 4); ovr[hf][j] = (v4u){0u, 0u, 0u, 0u};
                    if (tr < m.nvalid) ovr[hf][j] = *(const v4u*)(PROJ + (size_t)(m.rowbase + tr) * 3072 + 2048 + m.h * 256 + hf * 128 + (chunk & 15) * 8); }
            LDS_BARRIER();
            LAS unsigned char* Ost = Vs + wave * 4352;
            float inv[4], ss[4];
#pragma unroll
            for (int i = 0; i < 4; ++i) { const float den = __shfl(acc[16][i], lane & 48); inv[i] = 1.f / fmaxf(fabsf(den), 1.f); ss[i] = 0.f; }
#pragma unroll
            for (int t = 0; t < 16; ++t)
#pragma unroll
                for (int i = 0; i < 4; ++i) { const float hv = acc[t][i] * inv[i]; acc[t][i] = hv; ss[i] += hv * hv; }
#pragma unroll
            for (int i = 0; i < 4; ++i) { float q = ss[i]; q += __shfl_xor(q, 1); q += __shfl_xor(q, 2); q += __shfl_xor(q, 4); q += __shfl_xor(q, 8); ss[i] = rsqrtf(q * (1.f / 256.f) + 1e-6f); }
#pragma unroll
            for (int hf = 0; hf < 2; ++hf) {
#pragma unroll
                for (int t8 = 0; t8 < 8; ++t8) { const int t = hf * 8 + t8; const float gg = g_out[m.h * 256 + 16 * t + c16];
#pragma unroll
                    for (int i = 0; i < 4; ++i) *(LAS unsigned short*)(Ost + (4 * g4 + i) * 272 + (16 * t8 + c16) * 2) = (unsigned short)f2bf(acc[t][i] * ss[i] * gg); }
                __builtin_amdgcn_sched_barrier(0);
#pragma unroll
                for (int j = 0; j < 4; ++j) { const int chunk = j * 64 + lane, row = chunk >> 4, ch = chunk & 15, tr = 16 * rt + row;
                    const v4u hv = *(const LAS v4u*)(Ost + row * 272 + ch * 16);
                    if (tr < m.nvalid) {
                        const v4u ov = ovr[hf][j];
                        v4u o;
                        o.x = pk2(bflo(hv.x) / (1.f + __expf(-bflo(ov.x))), bfhi(hv.x) / (1.f + __expf(-bfhi(ov.x))));
                        o.y = pk2(bflo(hv.y) / (1.f + __expf(-bflo(ov.y))), bfhi(hv.y) / (1.f + __expf(-bfhi(ov.y))));
                        o.z = pk2(bflo(hv.z) / (1.f + __expf(-bflo(ov.z))), bfhi(hv.z) / (1.f + __expf(-bfhi(ov.z))));
                        o.w = pk2(bflo(hv.w) / (1.f + __expf(-bflo(ov.w))), bfhi(hv.w) / (1.f + __expf(-bfhi(ov.w))));
                        *(v4u*)(HM + (size_t)(m.rowbase + tr) * DM + m.h * 256 + hf * 128 + ch * 8) = o;
                    }
                }
                __builtin_amdgcn_sched_barrier(0);
            }
        }
    }
    __syncthreads();
}

template <class EpiFn>
__device__ __forceinline__ void skinny_gemm16(const bf16* A16, const bf16* Bt, int ntask, LAS unsigned char* lds, int bx, int G, int tid, int lane, int wave, const EpiFn& epi) {
    LAS f32x4* part = (LAS f32x4*)lds;
    const int c16 = lane & 15, g4 = lane >> 4;
    for (int task = bx; task < ntask; task += G) {
        const int n0 = task * 64;
        f32x4 acc[4];
#pragma unroll
        for (int t = 0; t < 4; ++t) acc[t] = (f32x4){0.f, 0.f, 0.f, 0.f};
        const bf16* ap = A16 + (size_t)c16 * 1024 + wave * 128 + 8 * g4;
        const bf16* bp = Bt + (size_t)(n0 + c16) * 1024 + wave * 128 + 8 * g4;
#pragma unroll
        for (int ks = 0; ks < 4; ++ks) {
            const bf16x8_t a = *(const bf16x8_t*)(ap + 32 * ks);
#pragma unroll
            for (int t = 0; t < 4; ++t) { const bf16x8_t b = *(const bf16x8_t*)(bp + (size_t)t * 16 * 1024 + 32 * ks); acc[t] = __builtin_amdgcn_mfma_f32_16x16x32_bf16(b, a, acc[t], 0, 0, 0); }
        }
        __syncthreads();
#pragma unroll
        for (int t = 0; t < 4; ++t) part[(wave * 4 + t) * 64 + lane] = acc[t];
        __syncthreads();
        if (wave == 0) {
#pragma unroll
            for (int t = 0; t < 4; ++t) { f32x4 s = part[t * 64 + lane];
#pragma unroll
                for (int w = 1; w < 8; ++w) s += part[(w * 4 + t) * 64 + lane];
                acc[t] = s; }
            epi(c16, n0, g4, acc);
        }
    }
    __syncthreads();
}

struct Args { const float* in[22]; float* out; unsigned char* ws; int ph_lo, ph_hi, li, pad; };
__global__ void __launch_bounds__(NWAVES * 64, 2) trunk_fwd(Args args) {
    extern __shared__ __attribute__((aligned(16))) unsigned char lds_raw[];
    LAS unsigned char* lds = (LAS unsigned char*)lds_raw;
    volatile LAS unsigned* MISC = (volatile LAS unsigned*)(lds + MISC_OFF);
    const int tid = threadIdx.x, lane = tid & 63, wave = __builtin_amdgcn_readfirstlane(tid >> 6);
    const int G = gridDim.x; const int bx = blockIdx.x; const int vcu = (G % 8 == 0) ? (bx % 8) * (G / 8) + bx / 8 : bx;
    const int gw = vcu * NWAVES + wave, NGW = G * NWAVES;
    unsigned char* ws = args.ws;
    gu32* ctl = (gu32*)(ws + WS_CTL);
    const float* x = args.in[0]; const float* meta = args.in[1]; const float* norm_mix = args.in[2]; const float* norm_ffn = args.in[3];
    const float* m_w_in = args.in[4]; const float* m_b_gate = args.in[5]; const float* m_g_out = args.in[6]; const float* m_w_out = args.in[7];
    const float* kv_norm = args.in[8]; const float* kv_w = args.in[9]; const float* kv_b_f = args.in[10]; const float* k_norm = args.in[11];
    const float* f_w_q = args.in[12]; const float* f_q_norm = args.in[13]; const float* f_w_o = args.in[14];
    const float* moe_w_group = args.in[15]; const float* moe_b_group = args.in[16]; const float* moe_w_router = args.in[17]; const float* moe_b_router = args.in[18];
    const float* moe_w_gate = args.in[19]; const float* moe_w_up = args.in[20]; const float* moe_w_down = args.in[21];
    float* out = args.out;
    bf16* Win_t = (bf16*)(ws + WS_WIN); bf16* Wout_t = (bf16*)(ws + WS_WOUT); bf16* Wkv_t = (bf16*)(ws + WS_WKV); bf16* Wq_t = (bf16*)(ws + WS_WQ); bf16* Wo_t = (bf16*)(ws + WS_WO);
    float* gates = (float*)(ws + WS_GATES); float* RS = (float*)(ws + WS_RS); float* LP = (float*)(ws + WS_Q);
    float* Fm = (float*)(ws + WS_FM); float* Fa = (float*)(ws + WS_FA); float* logf = (float*)(ws + WS_LOGF); int* list = (int*)(ws + WS_LIST);
    bf16* XN = (bf16*)(ws + WS_XN); bf16* PROJ = (bf16*)(ws + WS_PROJ); bf16* H1 = (bf16*)(ws + WS_H1); bf16* H2 = XN; bf16* H3 = H1;
    bf16* CinB = (bf16*)(ws + WS_CIN); bf16* KVL = (bf16*)(ws + WS_KVL); bf16* W1t = (bf16*)(ws + WS_W1T); bf16* W2t = (bf16*)(ws + WS_W2T); bf16* ACT = (bf16*)(ws + WS_ACT); LAS int* mtbl = (LAS int*)(lds + LDSCTL_OFF + 1024);
    bf16* Kb = (bf16*)(ws + WS_K); bf16* Vb = (bf16*)(ws + WS_V); bf16* Qb = (bf16*)(ws + WS_Q); bf16* AO = (bf16*)(ws + WS_AO);

    for (int u = tid; u < (LDS_BYTES - LDSCTL_OFF) / 4; u += NWAVES * 64) ((LAS unsigned*)(lds + LDSCTL_OFF))[u] = 0u;
    __syncthreads();
    XcdBarrier bar; bar.bar = (unsigned*)(ctl + CW_BAR); bar.x = 0; bar.st = nullptr;
    if (N_LAUNCHES == 1) bar = xcd_barrier_post((unsigned*)(ctl + CW_BAR), MISC + 8);
    const int lo = args.ph_lo, hi = args.ph_hi;
#ifndef PHASE_MASK
#define PHASE_MASK 0xFFFFF
#endif
#define IN(k) (((PHASE_MASK >> (k)) & 1) && lo <= (k) && (k) < hi)
#define SEAM(k) do { if (IN(k) && IN((k) + 1)) xcd_barrier(bar); } while (0)

    const TrPtrs TP{m_w_in, m_w_out, kv_w, f_w_q, f_w_o, moe_w_gate, moe_w_up, moe_w_down, kv_norm, norm_mix + DM, norm_ffn, Win_t, Wout_t, Wkv_t, Wq_t, Wo_t, W1t, W2t};
    if (IN(0)) { ph_prologue(x, meta, norm_mix, m_w_in, m_b_gate, TP, XN, gates, lds, gw, NGW, tid, lane, wave); }
    SEAM(0);
    if (IN(1)) {
        skinny_gemm16(XN + (size_t)TR * DM, Win_t, 48, lds, bx, G, tid, lane, wave, [&](int row, int n0, int g4, const f32x4 (&v)[4]) {
            const float sc = n0 < 512 ? 0.08838834764831845f : 1.f;
#pragma unroll
            for (int t = 0; t < 4; ++t) *(unsigned long long*)(PROJ + (size_t)(TR + row) * 3072 + n0 + 16 * t + 4 * g4) = pack4bf(v[t] * sc); });
        pg8::Gemm g{XN, Win_t, TR, 3072, 1024}; pg8::StaticOrder S; S.init(TR, 3072, G, bx);
        pg8::EpiBf16<0> E{PROJ, 3072, nullptr, 512, 512, 0.08838834764831845f};
        pg8::gemm_phase<pg8::EpiBf16<0>, pg8::StaticOrder, true, true>(lds + RING_OFF, g, S, E);
    }
    SEAM(1);
    if (IN(2)) { ml_kvloc(PROJ, gates, KVL, Fm, lds, bx, G, tid, lane, wave); }
    SEAM(2);
    if (IN(3)) { ml_scan(KVL, Fm, CinB, bx, G, tid);
        if (bx >= 136 && bx < G - 4) ph_transposes<0>(TP, (LAS float*)(lds + 32768 + wave * 8704), (bx - 136) * NWAVES + wave, (G - 4 - 136) * NWAVES, lane, 8192, 10240);
        ml_out(PROJ, gates, CinB, m_g_out, XN, lds, bx, G, tid, lane, wave, [&]() { xcd_barrier(bar); }); }
    SEAM(3);
    if (IN(4)) {
        skinny_gemm16(XN + (size_t)TR * DM, Wout_t, 16, lds, bx, G, tid, lane, wave, [&](int row, int n0, int g4, const f32x4 (&v)[4]) {
#pragma unroll
            for (int t = 0; t < 4; ++t) { const int c = n0 + 16 * t + 4 * g4; *(unsigned long long*)(H1 + (size_t)(TR + row) * DM + c) = pack4bf(*(const f32x4*)(meta + (size_t)row * DM + c) + v[t]); } });
        pg8::Gemm g{XN, Wout_t, TR, 1024, 1024}; pg8::StaticOrder S; S.init(TR, 1024, G, bx);
        pg8::EpiResB<false> E{x, H1};
        pg8::gemm_phase<pg8::EpiResB<false>, pg8::StaticOrder, true, true>(lds + RING_OFF, g, S, E);
    }
    SEAM(4);
    if (IN(5)) { ph_norm_router(H1, TALL, norm_ffn, moe_w_group, moe_b_group, moe_w_router, moe_b_router, LP, ctl + CW_CNT, list, lds, vcu, tid, lane, wave); }
    SEAM(5);
    if (IN(6)) {
        moe_tables(ctl + CW_CNT, mtbl, tid);
        { pg8::MoeSched<1> S{mtbl, list, (const char*)W1t, G, vcu, (unsigned*)(ctl + CW_RDY)}; pg8::Gemm2 g{(const char*)H1, 1024, 1024}; pg8::EpiMoe1 E{ACT, LP};
          pg8::gemm_phase2<pg8::EpiMoe1, pg8::MoeSched<1>>(lds + RING_OFF, (LAS unsigned*)(lds + LDSCTL_OFF + 2048), g, S, E); }
        { pg8::MoeSched<2> S{mtbl, list, (const char*)W2t, G, vcu, (unsigned*)(ctl + CW_RDY)}; pg8::Gemm2 g{(const char*)ACT, 512, 8192}; pg8::EpiMoe2R<false> E{H1, H2, list};
          pg8::gemm_phase2<pg8::EpiMoe2R<false>, pg8::MoeSched<2>>(lds + RING_OFF, (LAS unsigned*)(lds + LDSCTL_OFF + 2048), g, S, E); }
    }
    SEAM(6);
    if (IN(7)) { ph_norm_kvq(H2, kv_norm, kv_w, kv_b_f, RS, logf, Kb, Vb, lds, vcu, gw, NGW, tid, lane, wave); }
    SEAM(7);
    if (IN(9)) { ph_fk_scan(logf, f_q_norm, k_norm, Fa, (int*)(Fa + 32 * KVROWS), lds, bx >= G - 32 ? bx - (G - 32) : 64, tid, lane, wave);
        if (bx >= 32 && bx < G - 32) ph_transposes<1>(TP, (LAS float*)(lds + 32768 + wave * 8704), (bx - 32) * NWAVES + wave, (G - 64) * NWAVES, lane, 0, 6144);
        __syncthreads(); }
    if (IN(8)) {
        skinny_gemm16(H2 + (size_t)TR * DM, Wkv_t, 32, lds, bx, G, tid, lane, wave, [&](int row, int n0, int g4, const f32x4 (&v)[4]) {
            const bool isK = n0 < 1024; bf16* base = isK ? Kb : Vb; const int cb = isK ? n0 : n0 - 1024;
            float rstd = RS[TR + row];
            if (isK) { float ss = 0.f;
#pragma unroll
                for (int t = 0; t < 4; ++t) ss += dot4(v[t], v[t]);
                ss += __shfl_xor(ss, 16); ss += __shfl_xor(ss, 32); rstd = rstd * rsqrtf(ss * (rstd * rstd * (1.f / 64.f)) + 1e-6f); }
#pragma unroll
            for (int t = 0; t < 4; ++t) { f32x4 o = v[t] * rstd; if (isK) o = o * *(const f32x4*)(k_norm + 16 * t + 4 * g4);
                const unsigned long long w = pack4bf(o);
                *(unsigned long long*)(base + (size_t)row * DM + cb + 16 * t + 4 * g4) = w; *(unsigned long long*)(base + (size_t)(KVROWS + row) * DM + cb + 16 * t + 4 * g4) = w; } });
        { pg8::Gemm g{H2, Wkv_t, TR, 2048, 1024}; pg8::StaticOrder S; S.init(TR, 2048, G, bx);
          pg8::EpiKVN E{Kb, Vb, k_norm, RS};
          pg8::gemm_phase<pg8::EpiKVN, pg8::StaticOrder, true, true>(lds + RING_OFF, g, S, E); }
        { pg8::Gemm g{H2, Wq_t, TR, 1024, 1024}; pg8::StaticOrder S; S.init(TR, 1024, G, bx);
          static_assert(WS_Q - WS_RS == pg8::X_Q_TO_RS, "EpiQN finds the row scales relative to Qb");
          pg8::EpiQN E{Qb, f_q_norm, 0.125f * 1.4426950408889634f};
          pg8::gemm_phase<pg8::EpiQN, pg8::StaticOrder, true, true>(lds + RING_OFF, g, S, E); }
    }
    SEAM(9);
    if (IN(10)) {
        LAS float* fkl = (LAS float*)(lds + 86016);
        LAS int* keys = (LAS int*)(lds + 119040);
        LAS int* sinf = (LAS int*)(lds + 127232);
        LAS float* fq = (LAS float*)(lds + 131328);
        LAS int* scn = (LAS int*)(lds + 132352);
        const int* TS = (const int*)(Fa + 32 * KVROWS);
        float* pscr = (float*)(ws + WS_H1);
        { int tsv[2], fl[2], cnt2 = 0;
#pragma unroll
          for (int j = 0; j < 2; ++j) { const int i = 2 * tid + j; tsv[j] = TS[i]; fl[j] = (4 * (i & 31) + 5 - tsv[j]) >= 71 ? 1 : 0; cnt2 += fl[j]; }
          int incl = cnt2;
#pragma unroll
          for (int o = 1; o < 64; o <<= 1) { const int t = __shfl_up(incl, o); if (lane >= o) incl += t; }
          if (lane == 63) scn[wave] = incl;
          __syncthreads();
          int base = 0;
#pragma unroll
          for (int w = 0; w < 8; ++w) base += (w < wave) ? scn[w] : 0;
          int run = base + incl - cnt2;
#pragma unroll
          for (int j = 0; j < 2; ++j) { const int i = 2 * tid + j, c = 4 * (i & 31) + 5 - tsv[j]; const bool sp = fl[j] && run < 256;
              sinf[i] = (run << 8) | tsv[j];
              if (sp) { const int cA = ((c - 4) >> 1) & ~1; keys[2 * i] = ((cA + 1) << 12) | (1 << 10) | i; keys[2 * i + 1] = ((c - cA) << 12) | (2 << 10) | i; }
              else { keys[2 * i] = (c << 12) | i; keys[2 * i + 1] = 0; }
              run += fl[j]; } }
        { int kv[4];
          __syncthreads();
#pragma unroll
          for (int e = 0; e < 4; ++e) kv[e] = keys[4 * tid + e];
#pragma unroll
          for (int kk = 2; kk <= 2048; kk <<= 1) {
#pragma unroll
              for (int j = kk >> 1; j > 0; j >>= 1) {
                  if (j >= 256) {
                      LDS_BARRIER();
#pragma unroll
                      for (int e = 0; e < 4; ++e) keys[4 * tid + e] = kv[e];
                      LDS_BARRIER();
#pragma unroll
                      for (int e = 0; e < 4; ++e) { const int i = 4 * tid + e, p = keys[i ^ j]; const bool up = ((i & j) == 0) == ((i & kk) == 0); kv[e] = up ? max(kv[e], p) : min(kv[e], p); }
                  } else if (j >= 4) {
#pragma unroll
                      for (int e = 0; e < 4; ++e) { const int i = 4 * tid + e, p = __shfl_xor(kv[e], j >> 2); const bool up = ((i & j) == 0) == ((i & kk) == 0); kv[e] = up ? max(kv[e], p) : min(kv[e], p); }
                  } else {
#pragma unroll
                      for (int e = 0; e < 4; ++e) if ((e & j) == 0) { const int a = kv[e], b = kv[e | j]; const bool desc = ((4 * tid + e) & kk) == 0; const int hi = max(a, b), lo = min(a, b); kv[e] = desc ? hi : lo; kv[e | j] = desc ? lo : hi; }
                  }
              }
          }
          LDS_BARRIER();
#pragma unroll
          for (int e = 0; e < 4; ++e) keys[4 * tid + e] = kv[e]; }
        __syncthreads();
#pragma unroll 1
        for (int kq = 0; kq < 8; ++kq) {
            const int idx = (kq & 1) ? kq * 256 + 255 - vcu : kq * 256 + vcu;
            const int key = __builtin_amdgcn_readfirstlane(keys[idx]);
            if (key == 0) break;
            const int unit = key & 1023, part = (key >> 10) & 3, cost = key >> 12, bh = unit >> 5, qb = unit & 31;
            const int si = __builtin_amdgcn_readfirstlane(sinf[unit]), ts = si & 255, sj = si >> 8, c = 4 * qb + 5 - ts, cA = ((c - 4) >> 1) & ~1;
            const int tile0 = part == 2 ? ts + cA : ts;
            const float* fkg = Fa + (size_t)bh * KVROWS;
            __syncthreads();
            {
#pragma unroll 1
              for (int i = 4 * tid; i < 64 * cost; i += 2048) {
                  f32x4 f0 = *(const f32x4*)(fkg + 64 * tile0 + i);
                  if (part == 1 && i >= 64 * cA) f0 = (f32x4){__builtin_inff(), __builtin_inff(), __builtin_inff(), __builtin_inff()};
                  *(LAS f32x4*)(fkl + i) = f0; }
              if (tid < 256) fq[tid] = fkg[64 + 256 * qb + tid]; }
            __syncthreads();
            attn_body::attn_unit<12>(bh >> 4, bh & 15, qb, (const attn_body::bf16*)Qb, (const attn_body::bf16*)Kb, (const attn_body::bf16*)Vb, (attn_body::bf16*)AO, (char*)lds_raw + RING_OFF,
                                     fkl, fq, tile0, cost, part != 1, part ? pscr + (size_t)(2 * sj + part - 1) * (8 * 33 * 64) : (float*)nullptr);
        }
        xcd_barrier(bar);
        for (int i = tid; i < 1024; i += 512) { const int si = sinf[i]; if ((4 * (i & 31) + 5 - (si & 255)) >= 71 && (si >> 8) < 256) keys[si >> 8] = i; }
        __syncthreads();
        const int nsplit = __builtin_amdgcn_readfirstlane(scn[7] + 0 * tid) ;
        { int tot = 0;
#pragma unroll
          for (int w = 0; w < 8; ++w) tot += scn[w];
          const int ns = tot < 256 ? tot : 256;
          for (int sj = vcu; sj < ns; sj += G) {
              const int unit = __builtin_amdgcn_readfirstlane(keys[sj]), bh = unit >> 5, qb = unit & 31;
              const float* pa = pscr + (size_t)(2 * sj) * (8 * 33 * 64) + (size_t)wave * 33 * 64 + lane; const float* pb = pa + 8 * 33 * 64;
              attn_body::f32x16 o[2]; float l;
#pragma unroll
              for (int d0 = 0; d0 < 2; ++d0)
#pragma unroll
                  for (int r = 0; r < 16; ++r) o[d0][r] = pa[(d0 * 16 + r) * 64] + pb[(d0 * 16 + r) * 64];
              l = pa[32 * 64] + pb[32 * 64];
              attn_body::attn_finish(o, l, (attn_body::bf16*)AO + ((size_t)(bh >> 4) * SEQ + qb * 256 + wave * 32) * DM + (bh & 15) * 64, (char*)lds_raw + RING_OFF, wave, lane);
              asm volatile("s_waitcnt lgkmcnt(0)\n\ts_barrier" ::: "memory");
          } }
        (void)nsplit;
    }
    SEAM(10);
    if (IN(11)) {
        pg8::Gemm g{AO, Wo_t, TR, 1024, 1024}; pg8::StaticOrder S; S.init(TR, 1024, G, bx);
        pg8::EpiResB<true> E{H2, H3};
        pg8::gemm_phase<pg8::EpiResB<true>, pg8::StaticOrder, true, true>(lds + RING_OFF, g, S, E);
    }
    SEAM(11);
    if (IN(12)) { ph_norm_router(H3, TR, norm_ffn + DM, moe_w_group + 4096, moe_b_group + 4, moe_w_router + 16384, moe_b_router + 16, LP, ctl + CW_CNT + 1024, list, lds, vcu, tid, lane, wave); }
    SEAM(12);
    if (IN(13)) {
        moe_tables(ctl + CW_CNT + 1024, mtbl, tid);
        { pg8::MoeSched<1> S{mtbl, list, (const char*)(W1t + (size_t)16 * 512 * 1024), G, vcu, (unsigned*)(ctl + CW_RDY + 8192)}; pg8::Gemm2 g{(const char*)H3, 1024, 1024}; pg8::EpiMoe1 E{ACT, LP};
          pg8::gemm_phase2<pg8::EpiMoe1, pg8::MoeSched<1>>(lds + RING_OFF, (LAS unsigned*)(lds + LDSCTL_OFF + 2048), g, S, E); }
        { pg8::MoeSched<2> S{mtbl, list, (const char*)(W2t + (size_t)1024 * 8192), G, vcu, (unsigned*)(ctl + CW_RDY + 8192)}; pg8::Gemm2 g{(const char*)ACT, 512, 8192}; pg8::EpiMoe2R<true> E{H3, out, list};
          pg8::gemm_phase2<pg8::EpiMoe2R<true>, pg8::MoeSched<2>>(lds + RING_OFF, (LAS unsigned*)(lds + LDSCTL_OFF + 2048), g, S, E); }
    }
#undef IN
#undef SEAM
}

extern "C" void kernel_launch(void* const* d_in, const int* in_sizes, int n_in, void* d_out, int out_size, void* d_ws, size_t ws_size, hipStream_t stream) {
    static int grid = 0;
    if (grid == 0) {
        int dev = 0, cus = 0, per_cu = 0;
        if (hipGetDevice(&dev) != hipSuccess || hipDeviceGetAttribute(&cus, hipDeviceAttributeMultiprocessorCount, dev) != hipSuccess) { fprintf(stderr, "kernel_launch: device query failed\n"); grid = -1; return; }
        if (hipFuncSetAttribute((const void*)trunk_fwd, hipFuncAttributeMaxDynamicSharedMemorySize, LDS_BYTES) != hipSuccess) { fprintf(stderr, "kernel_launch: hipFuncSetAttribute failed\n"); grid = -1; return; }
        if (hipOccupancyMaxActiveBlocksPerMultiprocessor(&per_cu, (const void*)trunk_fwd, NWAVES * 64, LDS_BYTES) != hipSuccess || per_cu < 1)
            fprintf(stderr, "kernel_launch: note: occupancy query reports %d workgroups per CU\n", per_cu);
        (void)hipGetLastError();
        grid = cus;
    }
    if (grid < 0) return;
    if (hipMemsetAsync((char*)d_ws + WS_CTL, 0, CTL_ZERO_BYTES, stream) != hipSuccess) { fprintf(stderr, "kernel_launch: memset failed\n"); return; }
    Args a{};
    for (int i = 0; i < 22; ++i) a.in[i] = (const float*)d_in[i];
    a.out = (float*)d_out; a.ws = (unsigned char*)d_ws;
    if (N_LAUNCHES == 1) { a.ph_lo = 0; a.ph_hi = NPHASE; a.li = 0; hipLaunchKernelGGL(trunk_fwd, dim3(grid), dim3(NWAVES * 64), LDS_BYTES, stream, a); }
    else for (int li = 0; li < NPHASE; ++li) { a.ph_lo = li; a.ph_hi = li + 1; a.li = li; hipLaunchKernelGGL(trunk_fwd, dim3(grid), dim3(NWAVES * 64), LDS_BYTES, stream, a); }
    const hipError_t le = hipPeekAtLastError();
    if (le != hipSuccess) fprintf(stderr, "kernel_launch: launch failed: %s\n", hipGetErrorName(le));
}
```
